# Optimizing an MI355X kernel written in HIP

```python
import jax, jax.numpy as jnp
from jax import lax
import numpy as np

D_MODEL = 1024
BATCH = 16
SEQ = 256
DEPTH = 4
DEC_BATCH = 8
DEC_SEQ = 1024
PAST_LEN = 512

GRID_W = 64
N_MIXERS = 2
N_DELTA = (DEPTH + 1) // 2
N_ATTN = DEPTH // 2
DN_DK = 128
DN_DV = 128
DN_HEADS = D_MODEL // DN_DK
DN_CONV = 3
DN_CHUNK = 64
DN_KD = DN_HEADS * DN_DK
DN_VD = DN_HEADS * DN_DV
DN_QKV = 2 * DN_KD + DN_VD
DN_PROJ = DN_QKV + DN_VD + 4 * DN_HEADS
AT_HEAD_DIM = 64
AT_HEADS = D_MODEL // AT_HEAD_DIM
AT_KV_HEADS = AT_HEADS // 4
AT_GROUPS = AT_HEADS // AT_KV_HEADS
AT_WINDOW = 128
AT_QBLK = 128
AT_PROJ = (AT_HEADS + 2 * AT_KV_HEADS) * AT_HEAD_DIM
ROPE_BASE = 10000.0
FFN_DIM = ((8 * D_MODEL // 3 + 127) // 128) * 128
FFN_CONV = 3
EPS = 1e-6

kernel_name = "hybrid_deltanet_swa_diffusion_step"

F32 = jnp.float32


def rmsnorm(x, g):
    x32 = x.astype(F32)
    y = x32 * lax.rsqrt(jnp.mean(x32 * x32, axis=-1, keepdims=True) + EPS)
    return (y * g.astype(F32)).astype(x.dtype)


def l2norm(x):
    x32 = x.astype(F32)
    return x32 * lax.rsqrt(jnp.sum(x32 * x32, axis=-1, keepdims=True) + EPS)


def dwconv_centred(x, w, b=None):
    K = w.shape[0]
    pad = K // 2
    T = x.shape[1]
    xp = jnp.pad(x, ((0, 0), (pad, pad), (0, 0)))
    y = sum(xp[:, k:k + T] * w[k] for k in range(K))
    if b is not None:
        y = y + b
    return y


def modulation(cvec, w_ada, b_ada):
    m = (jax.nn.silu(cvec) @ w_ada + b_ada)[:, None, :]
    return jnp.split(m, 6, axis=-1)


def pre(x, g, shift, scale):
    return rmsnorm(x, g) * (1 + scale) + shift


def chunk_gated_delta(q, k, v, g, beta, s0):
    B, T, H, DK = q.shape
    DV = v.shape[-1]
    C = DN_CHUNK
    n = T // C

    def blocks(a):
        a = jnp.moveaxis(a.astype(F32), 2, 1)
        return a.reshape((a.shape[0], a.shape[1], n, C) + a.shape[3:])

    qc = blocks(q) * (DK ** -0.5)
    kc = blocks(k)
    vc = blocks(v)
    bc = blocks(beta)
    gc = jnp.cumsum(blocks(g), axis=-1)
    idx = jnp.arange(C)
    lower = idx[:, None] >= idx[None, :]
    strict = idx[:, None] > idx[None, :]
    decay = jnp.exp(jnp.where(lower, gc[..., :, None] - gc[..., None, :], -jnp.inf))
    kk = jnp.einsum('bhnik,bhnjk->bhnij', kc * bc[..., None], kc) * decay
    a_mat = jnp.where(strict, kk, 0.0) + jnp.eye(C, dtype=F32)
    rhs = jnp.concatenate([vc * bc[..., None], kc * (bc * jnp.exp(gc))[..., None]], axis=-1)
    sol = lax.linalg.triangular_solve(a_mat, rhs, left_side=True, lower=True, unit_diagonal=True)
    u, w = sol[..., :DV], sol[..., DV:]
    qk = jnp.where(lower, jnp.einsum('bhnik,bhnjk->bhnij', qc, kc) * decay, 0.0)

    def step(S, xs):
        q_i, k_i, u_i, w_i, g_i, qk_i = xs
        v_new = u_i - jnp.einsum('bhck,bhkv->bhcv', w_i, S)
        o_i = (jnp.einsum('bhck,bhkv->bhcv', q_i * jnp.exp(g_i)[..., None], S)
               + jnp.einsum('bhij,bhjv->bhiv', qk_i, v_new))
        g_last = g_i[..., -1]
        S = (S * jnp.exp(g_last)[..., None, None]
             + jnp.einsum('bhck,bhcv->bhkv', k_i * jnp.exp(g_last[..., None] - g_i)[..., None], v_new))
        return S, o_i

    xs = tuple(jnp.moveaxis(a, 2, 0) for a in (qc, kc, u, w, gc, qk))
    s_fin, o = lax.scan(step, s0.astype(F32), xs)
    o = jnp.transpose(o, (1, 0, 3, 2, 4)).reshape(B, T, H, DV)
    return o, s_fin


def gated_delta_mixer(h, s0, w_in, conv_w, a_log, dt_bias, onorm_g, w_out):
    B, T, _ = h.shape
    proj = h @ w_in
    qkv = jax.nn.silu(dwconv_centred(proj[..., :DN_QKV], conv_w))
    q = l2norm(qkv[..., :DN_KD].reshape(B, T, DN_HEADS, DN_DK))
    k = l2norm(qkv[..., DN_KD:2 * DN_KD].reshape(B, T, DN_HEADS, DN_DK))
    v = qkv[..., 2 * DN_KD:].reshape(B, T, DN_HEADS, DN_DV)
    z = proj[..., DN_QKV:DN_QKV + DN_VD].reshape(B, T, DN_HEADS, DN_DV)
    ab = proj[..., DN_QKV + DN_VD:].astype(F32).reshape(B, T, 2, 2, DN_HEADS)
    g = -jnp.exp(a_log.astype(F32)) * jax.nn.softplus(ab[:, :, 0] + dt_bias.astype(F32))
    beta = jax.nn.sigmoid(ab[:, :, 1])
    flip = lambda a: jnp.flip(a, axis=1)
    o_f, s_f = chunk_gated_delta(q, k, v, g[:, :, 0], beta[:, :, 0], s0[:, 0])
    o_b, s_b = chunk_gated_delta(flip(q), flip(k), flip(v), flip(g[:, :, 1]), flip(beta[:, :, 1]), s0[:, 1])
    o = o_f + flip(o_b)
    o = rmsnorm(o, onorm_g) * jax.nn.silu(z.astype(F32))
    y = o.reshape(B, T, DN_VD).astype(h.dtype) @ w_out
    return y, jnp.stack([s_f, s_b], axis=1).astype(h.dtype)


def attn_proj(h, w_qkv):
    B, T, _ = h.shape
    p = h @ w_qkv
    qd = AT_HEADS * AT_HEAD_DIM
    kd = AT_KV_HEADS * AT_HEAD_DIM
    q = p[..., :qd].reshape(B, T, AT_KV_HEADS, AT_GROUPS, AT_HEAD_DIM)
    k = p[..., qd:qd + kd].reshape(B, T, AT_KV_HEADS, AT_HEAD_DIM)
    v = p[..., qd + kd:].reshape(B, T, AT_KV_HEADS, AT_HEAD_DIM)
    return q, k, v


def rope2d(x):
    T = x.shape[1]
    rows = T // GRID_W
    pos = jnp.arange(rows * GRID_W)
    row = (pos // GRID_W).astype(F32)
    col = (pos % GRID_W).astype(F32)
    half = AT_HEAD_DIM // 2
    inv = jnp.power(ROPE_BASE, -jnp.arange(0, half, 2, dtype=F32) / half)

    def rot(xh, p):
        ang = (p[:, None] * inv).reshape((1, T) + (1,) * (x.ndim - 3) + (-1,))
        cos, sin = jnp.cos(ang), jnp.sin(ang)
        x1, x2 = jnp.split(xh.astype(F32), 2, axis=-1)
        return jnp.concatenate([x1 * cos - x2 * sin, x1 * sin + x2 * cos], axis=-1)

    return jnp.concatenate([rot(x[..., :half], row), rot(x[..., half:], col)], axis=-1).astype(x.dtype)


def softmax_with_sink(s, sink):
    sk = jnp.broadcast_to(sink.astype(F32).reshape(1, AT_KV_HEADS, AT_GROUPS, 1, 1), s.shape[:-1] + (1,))
    return jax.nn.softmax(jnp.concatenate([s, sk], axis=-1), axis=-1)[..., :-1]


def context_attention(q, k, v, sink):
    B, T = q.shape[:2]
    n = T // AT_QBLK
    scale = AT_HEAD_DIM ** -0.5
    qb = jnp.moveaxis(q.reshape(B, n, AT_QBLK, AT_KV_HEADS, AT_GROUPS, AT_HEAD_DIM), 1, 0)

    def blk(q_i):
        s = jnp.einsum('bqkgd,bskd->bkgqs', q_i, k, preferred_element_type=F32) * scale
        p = softmax_with_sink(s, sink)
        return jnp.einsum('bkgqs,bskd->bqkgd', p.astype(v.dtype), v)

    o = lax.map(blk, qb)
    return jnp.moveaxis(o, 0, 1).reshape(B, T, AT_HEADS * AT_HEAD_DIM)


def latent_attention(q, k, v, k_ctx, v_ctx, sink):
    B, T = q.shape[:2]
    n = T // AT_QBLK
    W = AT_WINDOW
    band = AT_QBLK + 2 * W
    scale = AT_HEAD_DIM ** -0.5
    kp = jnp.pad(k, ((0, 0), (W, W), (0, 0), (0, 0)))
    vp = jnp.pad(v, ((0, 0), (W, W), (0, 0), (0, 0)))
    qb = jnp.moveaxis(q.reshape(B, n, AT_QBLK, AT_KV_HEADS, AT_GROUPS, AT_HEAD_DIM), 1, 0)
    qi_idx = jnp.arange(AT_QBLK)
    kj_idx = jnp.arange(band)

    def blk(xs):
        q_i, b = xs
        start = b * AT_QBLK
        kb = lax.dynamic_slice_in_dim(kp, start, band, axis=1)
        vb = lax.dynamic_slice_in_dim(vp, start, band, axis=1)
        qpos = start + qi_idx
        kpos = start - W + kj_idx
        valid = (jnp.abs(qpos[:, None] - kpos[None, :]) <= W) & (kpos[None, :] >= 0) & (kpos[None, :] < T)
        s_loc = jnp.einsum('bqkgd,bskd->bkgqs', q_i, kb, preferred_element_type=F32) * scale
        s_loc = jnp.where(valid, s_loc, -jnp.inf)
        s_ctx = jnp.einsum('bqkgd,bskd->bkgqs', q_i, k_ctx, preferred_element_type=F32) * scale
        p = softmax_with_sink(jnp.concatenate([s_loc, s_ctx], axis=-1), sink).astype(v.dtype)
        return (jnp.einsum('bkgqs,bskd->bqkgd', p[..., :band], vb)
                + jnp.einsum('bkgqs,bskd->bqkgd', p[..., band:], v_ctx))

    o = lax.map(blk, (qb, jnp.arange(n)))
    return jnp.moveaxis(o, 0, 1).reshape(B, T, AT_HEADS * AT_HEAD_DIM)


def conv_ffn(h, w_up, conv_w, conv_b, w_down):
    u = dwconv_centred(h @ w_up, conv_w, conv_b)
    a, b = jnp.split(u, 2, axis=-1)
    return (jax.nn.silu(a) * b) @ w_down


def setup_inputs(seed: int = 0) -> dict:
    key = jax.random.key(seed)
    ks = jax.random.split(key, 24)
    nrm = lambda k, s, sc: jax.random.normal(k, s, F32) * sc
    D = D_MODEL
    return {
        "x_prompt": nrm(ks[0], (BATCH, SEQ, D), 1.0),
        "x_sample": nrm(ks[1], (DEC_BATCH, DEC_SEQ, D), 1.0),
        "state_delta": nrm(ks[2], (DEC_BATCH, N_DELTA, 2, DN_HEADS, DN_DK, DN_DV), 0.2),
        "cache_k": nrm(ks[3], (DEC_BATCH, N_ATTN, PAST_LEN, AT_KV_HEADS, AT_HEAD_DIM), 1.0),
        "cache_v": nrm(ks[4], (DEC_BATCH, N_ATTN, PAST_LEN, AT_KV_HEADS, AT_HEAD_DIM), 1.0),
        "c": nrm(ks[5], (DEC_BATCH, D), 1.0),
        "c_ctx": nrm(ks[6], (D,), 1.0),
        "w_ada": nrm(ks[7], (DEPTH, D, 6 * D), 0.5 * D ** -0.5),
        "b_ada": nrm(ks[8], (DEPTH, 6 * D), 0.02),
        "norm_g": 1.0 + nrm(ks[9], (DEPTH, 4, D), 0.1),
        "dn_w_in": nrm(ks[10], (N_DELTA, D, DN_PROJ), D ** -0.5),
        "dn_conv_w": nrm(ks[11], (N_DELTA, DN_CONV, DN_QKV), DN_CONV ** -0.5),
        "dn_a_log": jnp.log(jax.random.uniform(ks[12], (N_DELTA, 2, DN_HEADS), F32, 1.0, 16.0)),
        "dn_dt_bias": jax.random.uniform(ks[13], (N_DELTA, 2, DN_HEADS), F32, -4.6, -2.3),
        "dn_onorm_g": 1.0 + nrm(ks[14], (N_DELTA, DN_DV), 0.1),
        "dn_w_out": nrm(ks[15], (N_DELTA, DN_VD, D), DN_VD ** -0.5),
        "at_w_qkv": nrm(ks[16], (N_ATTN, D, AT_PROJ), D ** -0.5),
        "at_sink": nrm(ks[17], (N_ATTN, AT_HEADS), 0.5),
        "at_w_o": nrm(ks[18], (N_ATTN, AT_HEADS * AT_HEAD_DIM, D), (AT_HEADS * AT_HEAD_DIM) ** -0.5),
        "ffn_w_up": nrm(ks[19], (DEPTH, D, 2 * FFN_DIM), D ** -0.5),
        "ffn_conv_w": nrm(ks[20], (DEPTH, FFN_CONV, 2 * FFN_DIM), FFN_CONV ** -0.5),
        "ffn_conv_b": nrm(ks[21], (DEPTH, 2 * FFN_DIM), 0.02),
        "ffn_w_down": nrm(ks[22], (DEPTH, FFN_DIM, D), FFN_DIM ** -0.5),
    }


def reference(x_prompt, x_sample, state_delta, cache_k, cache_v, c, c_ctx,
              w_ada, b_ada, norm_g,
              dn_w_in, dn_conv_w, dn_a_log, dn_dt_bias, dn_onorm_g, dn_w_out,
              at_w_qkv, at_sink, at_w_o,
              ffn_w_up, ffn_conv_w, ffn_conv_b, ffn_w_down):
    xp, xs = x_prompt, x_sample
    st_new, ck_new, cv_new = [], [], []
    for i in range(DEPTH):
        j = i // N_MIXERS
        mp = modulation(c_ctx[None, :], w_ada[i], b_ada[i])
        ms = modulation(c, w_ada[i], b_ada[i])
        hp = pre(xp, norm_g[i, 0], mp[0], mp[1])
        hs = pre(xs, norm_g[i, 0], ms[0], ms[1])
        if i % N_MIXERS == 0:
            s_zero = jnp.zeros((xp.shape[0], 2, DN_HEADS, DN_DK, DN_DV), xp.dtype)
            yp, sp = gated_delta_mixer(hp, s_zero, dn_w_in[j], dn_conv_w[j], dn_a_log[j],
                                       dn_dt_bias[j], dn_onorm_g[j], dn_w_out[j])
            ys, _ = gated_delta_mixer(hs, state_delta[:, j], dn_w_in[j], dn_conv_w[j], dn_a_log[j],
                                      dn_dt_bias[j], dn_onorm_g[j], dn_w_out[j])
            st_new.append(sp)
        else:
            qp, kp, vp = attn_proj(hp, at_w_qkv[j])
            yp = context_attention(qp, kp, vp, at_sink[j]) @ at_w_o[j]
            qs, ks_, vs = attn_proj(hs, at_w_qkv[j])
            ys = latent_attention(rope2d(qs), rope2d(ks_), vs, cache_k[:, j], cache_v[:, j],
                                  at_sink[j]) @ at_w_o[j]
            ck_new.append(kp)
            cv_new.append(vp)
        xp = xp + mp[2] * rmsnorm(yp, norm_g[i, 1])
        xs = xs + ms[2] * rmsnorm(ys, norm_g[i, 1])
        hp = pre(xp, norm_g[i, 2], mp[3], mp[4])
        hs = pre(xs, norm_g[i, 2], ms[3], ms[4])
        fp = conv_ffn(hp, ffn_w_up[i], ffn_conv_w[i], ffn_conv_b[i], ffn_w_down[i])
        fs = conv_ffn(hs, ffn_w_up[i], ffn_conv_w[i], ffn_conv_b[i], ffn_w_down[i])
        xp = xp + mp[5] * rmsnorm(fp, norm_g[i, 3])
        xs = xs + ms[5] * rmsnorm(fs, norm_g[i, 3])
    y_prompt = xp
    y_sample = xs
    state_delta_new = jnp.stack(st_new, axis=1)
    cache_k_new = jnp.stack(ck_new, axis=1)
    cache_v_new = jnp.stack(cv_new, axis=1)
    return (y_prompt, y_sample, state_delta_new, cache_k_new, cache_v_new)
```

```cpp
#include <hip/hip_runtime.h>
#include <hip/hip_cooperative_groups.h>
#include <cstdio>
#include <cstring>
namespace cg = cooperative_groups;

#ifndef MULTI_LAUNCH
#define MULTI_LAUNCH 0
#endif

#define DI __device__ __forceinline__
typedef unsigned short bf16;
using bf16x8 = __attribute__((ext_vector_type(8))) short;
using f32x16 = __attribute__((ext_vector_type(16))) float;
using u32x4 = __attribute__((ext_vector_type(4))) unsigned;
typedef __bf16 bf16v2 __attribute__((ext_vector_type(2)));
typedef float f32v2 __attribute__((ext_vector_type(2)));
#define MFMA(a, b, c) __builtin_amdgcn_mfma_f32_32x32x16_bf16((a), (b), (c), 0, 0, 0)

DI unsigned pack2(float a, float b) { f32v2 v = {a, b}; bf16v2 r = __builtin_convertvector(v, bf16v2); return __builtin_bit_cast(unsigned, r); }
DI bf16 f2bf(float a) { return (bf16)(pack2(a, 0.f) & 0xffffu); }
DI float bf2f(bf16 b) { return __uint_as_float(((unsigned)b) << 16); }
DI float bflo(unsigned u) { return __uint_as_float(u << 16); }
DI float bfhi(unsigned u) { return __uint_as_float(u & 0xffff0000u); }
DI int crow(int reg, int h) { return (reg & 3) + 8 * (reg >> 2) + 4 * h; }
DI bf16x8 pack8(const f32x16& x, int s) {
  u32x4 p;
  p[0] = pack2(x[8 * s + 0], x[8 * s + 1]); p[1] = pack2(x[8 * s + 2], x[8 * s + 3]);
  p[2] = pack2(x[8 * s + 4], x[8 * s + 5]); p[3] = pack2(x[8 * s + 6], x[8 * s + 7]);
  return __builtin_bit_cast(bf16x8, p);
}
DI bf16x8 frag2(uint2 lo, uint2 hi) { u32x4 p = {lo.x, lo.y, hi.x, hi.y}; return __builtin_bit_cast(bf16x8, p); }
DI int lane_id_opaque() { unsigned z = 0u; asm volatile("" : "+v"(z)); return (int)__builtin_amdgcn_mbcnt_hi(~0u, __builtin_amdgcn_mbcnt_lo(~0u, z)); }
DI int get_tid(int wv) { return (wv << 6) | lane_id_opaque(); }
DI float shx(float v, int mask, int lane) { return __int_as_float(__builtin_amdgcn_ds_bpermute((lane ^ mask) << 2, __float_as_int(v))); }
DI float siluf(float x) { return x / (1.f + __expf(-x)); }

constexpr int DM = 1024, NTOK = 12288, NPR = 4096;
constexpr int DNP = 4128, DNPAD = 4352, FF = 2816, FF2 = 5632, ATP = 1536;
constexpr float EPS = 1e-6f;
DI int seq_of_row(int r) { return r < NPR ? (r >> 8) : 16 + ((r - NPR) >> 10); }
DI int seq_start(int s) { return s < 16 ? s * 256 : NPR + (s - 16) * 1024; }
DI int seq_len(int s) { return s < 16 ? 256 : 1024; }
DI int cond_of_row(int r) { return r < NPR ? 0 : 1 + ((r - NPR) >> 10); }

constexpr size_t OFF_MOD = 0;
constexpr size_t OFF_KC = 1u << 20;
constexpr size_t OFF_VCT = OFF_KC + 4194304;
constexpr size_t OFF_WIN = OFF_VCT + 4194304;
constexpr size_t SZ_WIN = (size_t)DNPAD * 1024 * 2;
constexpr size_t OFF_WOUT = OFF_WIN + 2 * SZ_WIN;
constexpr size_t SZ_WSQ = (size_t)1024 * 1024 * 2;
constexpr size_t OFF_WQKV = OFF_WOUT + 2 * SZ_WSQ;
constexpr size_t SZ_WQKV = (size_t)ATP * 1024 * 2;
constexpr size_t OFF_WO = OFF_WQKV + 2 * SZ_WQKV;
constexpr size_t OFF_WUP = OFF_WO + 2 * SZ_WSQ;
constexpr size_t SZ_WUP = (size_t)FF2 * 1024 * 2;
constexpr size_t OFF_WDN = OFF_WUP + 4 * SZ_WUP;
constexpr size_t SZ_WDN = (size_t)1024 * FF * 2;
constexpr size_t OFF_H = OFF_WDN + 4 * SZ_WDN;
constexpr size_t SZ_TB = (size_t)NTOK * 1024 * 2;
constexpr size_t OFF_P = OFF_H + SZ_TB;
constexpr size_t SZ_P = (size_t)NTOK * FF2 * 2;
constexpr size_t OFF_TB = OFF_P + (size_t)NTOK * DNP * 2;
constexpr size_t OFF_HALO = OFF_P + (64u << 20);
constexpr size_t OFF_A = OFF_P + SZ_P;
constexpr size_t OFF_DQ = OFF_A, OFF_DK = OFF_A + SZ_TB, OFF_DV = OFF_A + 2 * SZ_TB, OFF_QK = OFF_A + 3 * SZ_TB;
constexpr size_t OFF_GC = OFF_A + 4 * SZ_TB, OFF_BETA = OFF_GC + 3072 * 64 * 4;
constexpr size_t OFF_AQ = OFF_A, OFF_AK = OFF_A + SZ_TB, OFF_AVT = OFF_AK + (size_t)NTOK * 256 * 2;
constexpr size_t OFF_XB = OFF_BETA + 3072 * 64 * 4;
constexpr size_t WS_NEEDED = OFF_XB + SZ_TB;
static_assert(OFF_TB + SZ_TB <= OFF_A, "T buffer must fit in P tail");
static_assert(WS_NEEDED <= 402653184ull, "workspace too large");
static_assert((size_t)NTOK * FF * 2 <= WS_NEEDED - OFF_A, "act fits");
constexpr int OUT_STATE = 12582912, OUT_CK = 20971520, OUT_CV = 23068672;

constexpr int LDS_BYTES = 73728;
constexpr int NPH = 40;

struct Params {
  const float *x_prompt, *x_sample, *state_delta, *cache_k, *cache_v, *c, *c_ctx, *w_ada, *b_ada, *norm_g,
      *dn_w_in, *dn_conv_w, *dn_a_log, *dn_dt_bias, *dn_onorm_g, *dn_w_out, *at_w_qkv, *at_sink, *at_w_o,
      *ffn_w_up, *ffn_conv_w, *ffn_conv_b, *ffn_w_down;
  float* out;
  char* ws;
};

DI void phase_pre(const Params& P, int wv, int vb, int nvb, char* smem) {
  const int tid = get_tid(wv), lane = tid & 63, wave = tid >> 6;
  if (vb < 384) {
    float* sc = (float*)smem;
    float* red = (float*)(smem + 36864);
    for (int e = tid; e < 9 * 1024; e += 256) {
      int r = e >> 10, k = e & 1023;
      float v = r == 0 ? P.c_ctx[k] : P.c[(r - 1) * 1024 + k];
      sc[e] = v / (1.f + __expf(-v));
    }
    __syncthreads();
    float* mod = (float*)(P.ws + OFF_MOD);
    for (int tile = vb; tile < 384; tile += nvb) {
      const int l = tile / 96, n0 = (tile % 96) * 64;
      const int c4 = tid & 15, kr = tid >> 4;
      float acc[9][4];
#pragma unroll
      for (int r = 0; r < 9; ++r) { acc[r][0] = acc[r][1] = acc[r][2] = acc[r][3] = 0.f; }
      const float* wp = P.w_ada + (size_t)l * 1024 * 6144 + n0 + c4 * 4;
      for (int k = kr; k < 1024; k += 64) {
        float4 wq[4];
#pragma unroll
        for (int u = 0; u < 4; ++u) wq[u] = *(const float4*)(wp + (size_t)(k + 16 * u) * 6144);
#pragma unroll
        for (int u = 0; u < 4; ++u)
#pragma unroll
          for (int r = 0; r < 9; ++r) {
            const float s = sc[r * 1024 + k + 16 * u];
            acc[r][0] += s * wq[u].x; acc[r][1] += s * wq[u].y; acc[r][2] += s * wq[u].z; acc[r][3] += s * wq[u].w;
          }
      }
#pragma unroll
      for (int r = 0; r < 9; ++r)
#pragma unroll
        for (int e = 0; e < 4; ++e) {
          float v = acc[r][e];
          v += shx(v, 16, lane); v += shx(v, 32, lane);
          if (lane < 16) red[(wave * 9 + r) * 64 + c4 * 4 + e] = v;
        }
      __syncthreads();
      for (int e = tid; e < 9 * 64; e += 256) {
        int r = e >> 6, cc = e & 63;
        float v = red[(0 * 9 + r) * 64 + cc] + red[(1 * 9 + r) * 64 + cc] + red[(2 * 9 + r) * 64 + cc] + red[(3 * 9 + r) * 64 + cc];
        mod[(l * 9 + r) * 6144 + n0 + cc] = v + P.b_ada[l * 6144 + n0 + cc];
      }
      __syncthreads();
    }
  }
  __syncthreads();
  {
    float* tile = (float*)smem;
    for (int g = vb; g < 3104; g += nvb) {
      const int t = g * 4;
      const float* src; bf16* dst; int K, N, Npad, lt, isup = 0;
      if (t < 2176) { int i = t / 1088; lt = t % 1088; src = P.dn_w_in + (size_t)i * 1024 * DNP; dst = (bf16*)(P.ws + OFF_WIN + i * SZ_WIN); K = 1024; N = DNP; Npad = DNPAD; }
      else if (t < 2688) { int u = t - 2176; int i = u / 256; lt = u % 256; src = P.dn_w_out + (size_t)i * 1024 * 1024; dst = (bf16*)(P.ws + OFF_WOUT + i * SZ_WSQ); K = 1024; N = 1024; Npad = 1024; }
      else if (t < 3456) { int u = t - 2688; int i = u / 384; lt = u % 384; src = P.at_w_qkv + (size_t)i * 1024 * ATP; dst = (bf16*)(P.ws + OFF_WQKV + i * SZ_WQKV); K = 1024; N = ATP; Npad = ATP; }
      else if (t < 3968) { int u = t - 3456; int i = u / 256; lt = u % 256; src = P.at_w_o + (size_t)i * 1024 * 1024; dst = (bf16*)(P.ws + OFF_WO + i * SZ_WSQ); K = 1024; N = 1024; Npad = 1024; }
      else if (t < 9600) { int u = t - 3968; int i = u / 1408; lt = u % 1408; src = P.ffn_w_up + (size_t)i * 1024 * FF2; dst = (bf16*)(P.ws + OFF_WUP + i * SZ_WUP); K = 1024; N = FF2; Npad = FF2; isup = 1; }
      else { int u = t - 9600; int i = u / 704; lt = u % 704; src = P.ffn_w_down + (size_t)i * FF * 1024; dst = (bf16*)(P.ws + OFF_WDN + i * SZ_WDN); K = FF; N = 1024; Npad = 1024; }
      const int NT = Npad / 64;
      const int k0 = (lt / NT) * 64, n00 = (lt % NT) * 64;
      {
        const int r = tid >> 4, c4 = (tid & 15) * 4;
#pragma unroll
        for (int q = 0; q < 4; ++q) {
          const int n0 = n00 + 64 * q;
          const int ns0 = isup ? ((n0 & 255) < 128 ? (n0 >> 8) * 128 + (n0 & 127) : FF + (n0 >> 8) * 128 + (n0 & 127)) : n0;
#pragma unroll
          for (int i = 0; i < 4; ++i) {
            const int k = k0 + r + 16 * i, n = ns0 + c4;
            float4 v = make_float4(0.f, 0.f, 0.f, 0.f);
            if (n < N) v = *(const float4*)(src + (size_t)k * N + n);
            float* tp = tile + q * 4160 + (r + 16 * i) * 65 + c4;
            tp[0] = v.x; tp[1] = v.y; tp[2] = v.z; tp[3] = v.w;
          }
        }
      }
      __syncthreads();
      {
        const int n = tid >> 2, kq = tid & 3;
#pragma unroll
        for (int q = 0; q < 4; ++q) {
          unsigned pk[8];
#pragma unroll
          for (int e = 0; e < 8; ++e) pk[e] = pack2(tile[q * 4160 + (kq * 16 + 2 * e) * 65 + n], tile[q * 4160 + (kq * 16 + 2 * e + 1) * 65 + n]);
          uint4* dp = (uint4*)(dst + (size_t)(n00 + 64 * q + n) * K + k0 + kq * 16);
          dp[0] = make_uint4(pk[0], pk[1], pk[2], pk[3]);
          dp[1] = make_uint4(pk[4], pk[5], pk[6], pk[7]);
        }
      }
      __syncthreads();
    }
  }
  {
    bf16* Kc = (bf16*)(P.ws + OFF_KC);
    bf16* Vct = (bf16*)(P.ws + OFF_VCT);
    const int nth = nvb * 256;
    for (int idx = vb * 256 + tid; idx < 2097152; idx += nth) {
      {
        int d = idx & 63, s = (idx >> 6) & 511, kvh = (idx >> 15) & 3, bj = idx >> 17;
        Kc[idx] = f2bf(P.cache_k[((bj * 512 + s) * 4 + kvh) * 64 + d]);
      }
      {
        int s = idx & 511, d = (idx >> 9) & 63, kvh = (idx >> 15) & 3, bj = idx >> 17;
        Vct[idx] = f2bf(P.cache_v[((bj * 512 + s) * 4 + kvh) * 64 + d]);
      }
    }
  }
}

DI void phase_rowepi(const Params& P, int wv, int vb, int nvb, int mode, const float* ga, const float* modg, int gate_idx,
                     int do_h, const float* gb, const float* modn, int shift_idx, int scale_idx) {
  const int lane = get_tid(wv) & 63, wave = get_tid(wv) >> 6;
  const bf16* Y = (const bf16*)(P.ws + OFF_P);
  bf16* H = (bf16*)(P.ws + OFF_H);
  bf16* XBp = (bf16*)(P.ws + OFF_XB);
  const int nw = nvb * 4;
  for (int row = vb * 4 + wave; row < NTOK; row += nw) {
    const int c = cond_of_row(row);
    float x[16];
    float* xo = P.out + (size_t)row * 1024;
    if (mode == 0) {
      const float* src = row < NPR ? P.x_prompt + (size_t)row * 1024 : P.x_sample + (size_t)(row - NPR) * 1024;
#pragma unroll
      for (int j = 0; j < 4; ++j) {
        float4 v = *(const float4*)(src + j * 256 + lane * 4);
        x[4 * j] = v.x; x[4 * j + 1] = v.y; x[4 * j + 2] = v.z; x[4 * j + 3] = v.w;
      }
    } else {
      float y[16];
      float ss = 0.f;
#pragma unroll
      for (int j = 0; j < 4; ++j) {
        const uint2 yu = *(const uint2*)(Y + (size_t)row * 1024 + j * 256 + lane * 4);
        float4 v; v.x = bflo(yu.x); v.y = bfhi(yu.x); v.z = bflo(yu.y); v.w = bfhi(yu.y);
        y[4 * j] = v.x; y[4 * j + 1] = v.y; y[4 * j + 2] = v.z; y[4 * j + 3] = v.w;
        ss += v.x * v.x + v.y * v.y + v.z * v.z + v.w * v.w;
        const uint2 xu = *(const uint2*)(XBp + (size_t)row * 1024 + j * 256 + lane * 4);
        x[4 * j] = bflo(xu.x); x[4 * j + 1] = bfhi(xu.x); x[4 * j + 2] = bflo(xu.y); x[4 * j + 3] = bfhi(xu.y);
      }
#pragma unroll
      for (int o = 32; o > 0; o >>= 1) ss += shx(ss, o, lane);
      const float rstd = rsqrtf(ss * (1.f / 1024.f) + EPS);
#pragma unroll
      for (int j = 0; j < 4; ++j) {
        const int col = j * 256 + lane * 4;
        float4 g = *(const float4*)(ga + col);
        float4 gt = *(const float4*)(modg + c * 6144 + gate_idx * 1024 + col);
        x[4 * j] += gt.x * (y[4 * j] * rstd * g.x);
        x[4 * j + 1] += gt.y * (y[4 * j + 1] * rstd * g.y);
        x[4 * j + 2] += gt.z * (y[4 * j + 2] * rstd * g.z);
        x[4 * j + 3] += gt.w * (y[4 * j + 3] * rstd * g.w);
      }
    }
    if (do_h) {
#pragma unroll
      for (int j = 0; j < 4; ++j) *(uint2*)(XBp + (size_t)row * 1024 + j * 256 + lane * 4) = make_uint2(pack2(x[4 * j], x[4 * j + 1]), pack2(x[4 * j + 2], x[4 * j + 3]));
    } else {
#pragma unroll
      for (int j = 0; j < 4; ++j) *(float4*)(xo + j * 256 + lane * 4) = make_float4(x[4 * j], x[4 * j + 1], x[4 * j + 2], x[4 * j + 3]);
    }
    if (do_h) {
      float ss = 0.f;
#pragma unroll
      for (int j = 0; j < 16; ++j) ss += x[j] * x[j];
#pragma unroll
      for (int o = 32; o > 0; o >>= 1) ss += shx(ss, o, lane);
      const float rstd = rsqrtf(ss * (1.f / 1024.f) + EPS);
#pragma unroll
      for (int j = 0; j < 4; ++j) {
        const int col = j * 256 + lane * 4;
        float4 g = *(const float4*)(gb + col);
        float4 sc = *(const float4*)(modn + c * 6144 + scale_idx * 1024 + col);
        float4 sh = *(const float4*)(modn + c * 6144 + shift_idx * 1024 + col);
        float h0 = x[4 * j] * rstd * g.x * (1.f + sc.x) + sh.x;
        float h1 = x[4 * j + 1] * rstd * g.y * (1.f + sc.y) + sh.y;
        float h2 = x[4 * j + 2] * rstd * g.z * (1.f + sc.z) + sh.z;
        float h3 = x[4 * j + 3] * rstd * g.w * (1.f + sc.w) + sh.w;
        *(uint2*)(H + (size_t)row * 1024 + col) = make_uint2(pack2(h0, h1), pack2(h2, h3));
      }
    }
  }
}

#define WAIT_VM(n) asm volatile("s_waitcnt vmcnt(%0)" ::"n"(n) : "memory")
#define RAW_BARRIER() do { asm volatile("s_waitcnt lgkmcnt(0)" ::: "memory"); __builtin_amdgcn_s_barrier(); } while (0)
using f32x4 = __attribute__((ext_vector_type(4))) float;
DI int g8_lds_byte(int r, int c) {
  int st = (r >> 4) * 2 + (c >> 5), rr = r & 15, cc = c & 31, ob = rr * 64 + cc * 2;
  return st * 1024 + (ob ^ (((ob >> 9) & 1) << 5));
}
DI void g8_stage_rc(int b, int& R, int& C) {
  int st = b / 1024, sb = b % 1024, swz = sb ^ (((sb >> 9) & 1) << 5);
  R = (st >> 1) * 16 + swz / 64; C = (st & 1) * 32 + (swz % 64) / 2;
}
DI void phase_gemm(int wv8, const bf16* __restrict__ A, int lda, const bf16* __restrict__ Bt, int K, int Npad, int N,
                   void* Cv, int ldc, int epi, const float* convw, const float* convb, bf16* halo, const Params& P, int jat, char* smem) {
  constexpr int HALF = 128, BK = 64, HT = HALF * BK;
  bf16* shm = (bf16*)smem;
  const int tid = get_tid(wv8) & 511;
  const int wid = tid >> 6, lane = tid & 63, wr = wid >> 2, wc = wid & 3, fr = lane & 15, fq = lane >> 4;
  (void)lda;
  const unsigned g8_ob = (unsigned)(fr * 64 + fq * 16), g8_obs = g8_ob ^ (((g8_ob >> 9) & 1u) << 5);
  const unsigned aA = (unsigned)(size_t)smem + (unsigned)(wr * 8192) + g8_obs;
  const unsigned aB = (unsigned)(size_t)smem + 65536u + (unsigned)(wc * 4096) + g8_obs;
  unsigned voff[2];
#pragma unroll
  for (int i = 0; i < 2; ++i) { int R_, C_; g8_stage_rc(tid * 16 + i * 8192, R_, C_); voff[i] = (unsigned)((R_ * K + C_) * 2); }
#define SA(b, hh) (shm + ((b) * 2 + (hh)) * HT)
#define SB(b, hh) (shm + (4 + (b) * 2 + (hh)) * HT)
#define STAGE(Pp, BASE, br, kt) do { const size_t _gu = (size_t)((BASE) + (long)(br) * K + (long)(kt) * BK);     \
    const char* _gb = (const char*)(((size_t)(unsigned)__builtin_amdgcn_readfirstlane((int)(_gu >> 32)) << 32) |   \
                                    (size_t)(unsigned)__builtin_amdgcn_readfirstlane((int)(unsigned)_gu));     \
    _Pragma("unroll") for (int _i = 0; _i < 2; ++_i)                                                                \
      __builtin_amdgcn_global_load_lds((const unsigned*)(_gb + voff[_i]),                                           \
        (unsigned*)((char*)(Pp) + tid * 16 + _i * 8192), 16, 0, 0); } while (0)
#define LDSR(dst, addr, off) asm volatile("ds_read_b128 %0, %1 offset:%2" : "=v"(dst) : "v"(addr), "n"(off) : "memory")
#define LDA(dst, b, hh) do {                                                                                        \
    LDSR(dst[0][0], aA, ((b) * 2 + (hh)) * 16384 + 0 * 2048 + 0);    LDSR(dst[0][1], aA, ((b) * 2 + (hh)) * 16384 + 0 * 2048 + 1024); \
    LDSR(dst[1][0], aA, ((b) * 2 + (hh)) * 16384 + 1 * 2048 + 0);    LDSR(dst[1][1], aA, ((b) * 2 + (hh)) * 16384 + 1 * 2048 + 1024); \
    LDSR(dst[2][0], aA, ((b) * 2 + (hh)) * 16384 + 2 * 2048 + 0);    LDSR(dst[2][1], aA, ((b) * 2 + (hh)) * 16384 + 2 * 2048 + 1024); \
    LDSR(dst[3][0], aA, ((b) * 2 + (hh)) * 16384 + 3 * 2048 + 0);    LDSR(dst[3][1], aA, ((b) * 2 + (hh)) * 16384 + 3 * 2048 + 1024); } while (0)
#define LDB(dst, b, hh) do {                                                                                        \
    LDSR(dst[0][0], aB, ((b) * 2 + (hh)) * 16384 + 0 * 2048 + 0);    LDSR(dst[0][1], aB, ((b) * 2 + (hh)) * 16384 + 0 * 2048 + 1024); \
    LDSR(dst[1][0], aB, ((b) * 2 + (hh)) * 16384 + 1 * 2048 + 0);    LDSR(dst[1][1], aB, ((b) * 2 + (hh)) * 16384 + 1 * 2048 + 1024); } while (0)
#define TIE_A(x) asm volatile("" : "+v"(x[0][0]), "+v"(x[0][1]), "+v"(x[1][0]), "+v"(x[1][1]), "+v"(x[2][0]), "+v"(x[2][1]), "+v"(x[3][0]), "+v"(x[3][1]) :: "memory")
#define TIE_B(x) asm volatile("" : "+v"(x[0][0]), "+v"(x[0][1]), "+v"(x[1][0]), "+v"(x[1][1]) :: "memory")
#define MMA(ai, bj, At_, Bt_) do { TIE_A(At_); TIE_B(Bt_); if (mma_all || ((bj) == 0 && wc == 0)) { __builtin_amdgcn_s_setprio(1);             \
    _Pragma("unroll") for (int m = 0; m < 4; ++m) _Pragma("unroll") for (int n = 0; n < 2; ++n) _Pragma("unroll") for (int k = 0; k < 2; ++k) \
      acc[ai][bj][m][n] = __builtin_amdgcn_mfma_f32_16x16x32_bf16(At_[m][k], Bt_[n][k], acc[ai][bj][m][n], 0, 0, 0); \
    __builtin_amdgcn_s_setprio(0); } } while (0)
#define WAIT_V(n) asm volatile("s_waitcnt vmcnt(" #n ")" ::: "memory")
#define WAIT_L(n) asm volatile("s_waitcnt lgkmcnt(" #n ")" ::: "memory")
#define BAR __builtin_amdgcn_s_barrier()
#define SCHED __builtin_amdgcn_sched_barrier(0)
  const int nN = Npad / 256, ntiles = (NTOK / 256) * nN, nt = K / BK;
  for (int tile = blockIdx.x; tile < ntiles; tile += gridDim.x) {
    const int tmt = tile % 48, tnt = tile / 48;
    const int brow = tmt * 256, bcol = tnt * 256;
    f32x4 acc[2][2][4][2];
#pragma unroll
    for (int a = 0; a < 2; ++a)
#pragma unroll
      for (int b = 0; b < 2; ++b)
#pragma unroll
        for (int m = 0; m < 4; ++m)
#pragma unroll
          for (int n = 0; n < 2; ++n) acc[a][b][m][n] = f32x4{0.f, 0.f, 0.f, 0.f};
    bf16x8 At[4][2], B0[2][2], B1[2][2];
    const bool mma_all = !(N - bcol <= 32);
    WAIT_V(0);
    STAGE(SB(0, 0), Bt, bcol, 0); STAGE(SA(0, 0), A, brow, 0);
    STAGE(SB(0, 1), Bt, bcol + HALF, 0); STAGE(SA(0, 1), A, brow + HALF, 0);
    if (wr == 1) BAR;
    WAIT_V(4); BAR;
    STAGE(SB(1, 0), Bt, bcol, 1); STAGE(SA(1, 0), A, brow, 1); STAGE(SB(1, 1), Bt, bcol + HALF, 1);
    WAIT_V(6); BAR;
    for (int t = 0; t < nt - 2; t += 2) {
      LDB(B0, 0, 0); SCHED; LDA(At, 0, 0); STAGE(SA(1, 1), A, brow + HALF, t + 1);
      WAIT_L(8); BAR; WAIT_L(0); MMA(0, 0, At, B0); BAR; SCHED;
      LDB(B1, 0, 1); STAGE(SB(0, 0), Bt, bcol, t + 2);
      BAR; WAIT_L(0); MMA(0, 1, At, B1); BAR;
      LDA(At, 0, 1); STAGE(SA(0, 0), A, brow, t + 2);
      BAR; WAIT_L(0); MMA(1, 0, At, B0); BAR; SCHED;
      STAGE(SB(0, 1), Bt, bcol + HALF, t + 2);
      WAIT_V(6); BAR; MMA(1, 1, At, B1); BAR;
      LDB(B0, 1, 0); SCHED; LDA(At, 1, 0); STAGE(SA(0, 1), A, brow + HALF, t + 2);
      WAIT_L(8); BAR; WAIT_L(0); MMA(0, 0, At, B0); BAR; SCHED;
      LDB(B1, 1, 1); STAGE(SB(1, 0), Bt, bcol, t + 3);
      BAR; WAIT_L(0); MMA(0, 1, At, B1); BAR;
      LDA(At, 1, 1); STAGE(SA(1, 0), A, brow, t + 3);
      BAR; WAIT_L(0); MMA(1, 0, At, B0); BAR; SCHED;
      STAGE(SB(1, 1), Bt, bcol + HALF, t + 3);
      WAIT_V(6); BAR; MMA(1, 1, At, B1); BAR;
    }
    { LDB(B0, 0, 0); LDA(At, 0, 0); STAGE(SA(1, 1), A, brow + HALF, nt - 1);
      BAR; WAIT_L(0); MMA(0, 0, At, B0); BAR;
      LDB(B1, 0, 1); BAR; WAIT_L(0); MMA(0, 1, At, B1); BAR;
      LDA(At, 0, 1); WAIT_V(4); BAR; WAIT_L(0); MMA(1, 0, At, B0); MMA(1, 1, At, B1); BAR; }
    { LDB(B0, 1, 0); LDA(At, 1, 0); WAIT_V(2); BAR; WAIT_L(0); MMA(0, 0, At, B0); BAR;
      LDB(B1, 1, 1); WAIT_V(0); BAR; WAIT_L(0); MMA(0, 1, At, B1); BAR;
      LDA(At, 1, 1); BAR; WAIT_L(0); MMA(1, 0, At, B0); MMA(1, 1, At, B1); BAR; }
    if (wr == 0) BAR;
    if (epi >= 3) {
      bf16* Plw = (bf16*)smem;
      int pb = (wr * 64 + fq * 4) * 268 + wc * 32 + fr;
      asm volatile("" : "+v"(pb));
#pragma unroll
      for (int ai = 0; ai < 2; ++ai)
#pragma unroll
        for (int bj = 0; bj < 2; ++bj)
#pragma unroll
          for (int m = 0; m < 4; ++m)
#pragma unroll
            for (int n = 0; n < 2; ++n)
#pragma unroll
              for (int jj = 0; jj < 4; ++jj)
                Plw[pb + (ai * HALF + m * 16 + jj) * 268 + bj * HALF + n * 16] = f2bf(acc[ai][bj][m][n][jj]);
      __syncthreads();
    }
    if (epi == 4) {
      bf16* Pl = (bf16*)smem;
      const int nb = tnt, mt = tmt;
      {
        int tidq = tid;
        asm volatile("" : "+v"(tidq));
        const bool smp = mt >= 16;
        const int sq = smp ? 16 + ((mt - 16) >> 2) : mt;
        const int ssq = seq_start(sq), lenq = seq_len(sq);
        const int tb = brow - ssq;
        if (nb < 5) {
          const int row = tidq >> 1, hsel = tidq & 1;
          const int tpos = tb + row;
          const float scl = nb < 4 ? 0.125f : 1.f;
#pragma unroll 1
          for (int hh = 0; hh < 4; ++hh) {
            const int hl = hh >> 1, hb = hh & 1;
            const int colh = hsel * 128 + hl * 64 + hb * 32;
            const bf16* src = Pl + row * 268 + colh;
            float v[32];
#pragma unroll
            for (int c8 = 0; c8 < 4; ++c8) {
              const uint2 ua_ = *(const uint2*)(src + c8 * 8), ub_ = *(const uint2*)(src + c8 * 8 + 4);
              const uint4 u = make_uint4(ua_.x, ua_.y, ub_.x, ub_.y);
              v[c8 * 8 + 0] = bflo(u.x); v[c8 * 8 + 1] = bfhi(u.x); v[c8 * 8 + 2] = bflo(u.y); v[c8 * 8 + 3] = bfhi(u.y);
              v[c8 * 8 + 4] = bflo(u.z); v[c8 * 8 + 5] = bfhi(u.z); v[c8 * 8 + 6] = bflo(u.w); v[c8 * 8 + 7] = bfhi(u.w);
            }
            if (nb == 4 && !smp) {
              float* ck = P.out + OUT_CK + ((size_t)((sq * 2 + jat) * 256 + tpos)) * 256 + colh;
#pragma unroll
              for (int c4 = 0; c4 < 8; ++c4) *(float4*)(ck + c4 * 4) = make_float4(v[c4 * 4], v[c4 * 4 + 1], v[c4 * 4 + 2], v[c4 * 4 + 3]);
            }
            float o[32];
            const float pp = (float)(hb ? (tpos & 63) : (tpos >> 6));
#pragma unroll
            for (int f = 0; f < 16; ++f) {
              float c_ = 1.f, s_ = 0.f;
              if (smp) { const float ang = pp * exp2f(-(float)f * (13.287712379549449f / 16.f)); c_ = __cosf(ang); s_ = __sinf(ang); }
              const float x1 = v[f], x2 = v[16 + f];
              o[f] = x1 * c_ - x2 * s_;
              o[16 + f] = x1 * s_ + x2 * c_;
            }
            bf16* dst = nb < 4 ? (bf16*)(P.ws + OFF_AQ) + (size_t)(brow + row) * 1024 + nb * 256 + colh
                               : (bf16*)(P.ws + OFF_AK) + (size_t)(brow + row) * 256 + colh;
#pragma unroll
            for (int c8 = 0; c8 < 4; ++c8)
              *(uint4*)(dst + c8 * 8) = make_uint4(pack2(o[c8 * 8] * scl, o[c8 * 8 + 1] * scl), pack2(o[c8 * 8 + 2] * scl, o[c8 * 8 + 3] * scl),
                                                   pack2(o[c8 * 8 + 4] * scl, o[c8 * 8 + 5] * scl), pack2(o[c8 * 8 + 6] * scl, o[c8 * 8 + 7] * scl));
          }
        } else {
          const int c = tidq & 255, rh = tidq >> 8;
          bf16* vt = (bf16*)(P.ws + OFF_AVT) + (size_t)ssq * 256 + (size_t)c * lenq + tb + rh * 128;
#pragma unroll 4
          for (int g8 = 0; g8 < 16; ++g8) {
            unsigned short e[8];
#pragma unroll
            for (int q = 0; q < 8; ++q) e[q] = Pl[(rh * 128 + g8 * 8 + q) * 268 + c];
            *(uint4*)(vt + g8 * 8) = make_uint4((unsigned)e[0] | ((unsigned)e[1] << 16), (unsigned)e[2] | ((unsigned)e[3] << 16),
                                                 (unsigned)e[4] | ((unsigned)e[5] << 16), (unsigned)e[6] | ((unsigned)e[7] << 16));
          }
          if (!smp) {
            const int row = tidq >> 1, hsel = tidq & 1;
            float* cv = P.out + OUT_CV + ((size_t)((sq * 2 + jat) * 256 + tb + row)) * 256 + hsel * 128;
            const bf16* src = Pl + row * 268 + hsel * 128;
#pragma unroll 4
            for (int c8 = 0; c8 < 16; ++c8) {
              const uint2 ua_ = *(const uint2*)(src + c8 * 8), ub_ = *(const uint2*)(src + c8 * 8 + 4);
              const uint4 u = make_uint4(ua_.x, ua_.y, ub_.x, ub_.y);
              *(float4*)(cv + c8 * 8) = make_float4(bflo(u.x), bfhi(u.x), bflo(u.y), bfhi(u.y));
              *(float4*)(cv + c8 * 8 + 4) = make_float4(bflo(u.z), bfhi(u.z), bflo(u.w), bfhi(u.w));
            }
          }
        }
      }
      __syncthreads();
      continue;
    }
    if (epi == 3) {
      bf16* Pl = (bf16*)smem;
      const int nb = tnt, mt = tmt;
      {
        const int fl = tid & 127, strip = tid >> 7, r0 = strip * 64;
        const int f = nb * 128 + fl;
        const float* cw = (const float*)convw;
        const float* cbv = (const float*)convb;
        const float wa0 = cw[f], wa1 = cw[FF2 + f], wa2 = cw[2 * FF2 + f], ba = cbv[f];
        const float wb0 = cw[FF + f], wb1 = cw[FF2 + FF + f], wb2 = cw[2 * FF2 + FF + f], bb = cbv[FF + f];
        const bool smp = mt >= 16;
        const int qd = (mt - 16) & 3;
        const bool defer0 = smp && qd != 0, defer255 = smp && qd != 3;
        bf16* actp = (bf16*)Cv + (size_t)brow * FF + f;
        float pa = 0.f, pb = 0.f;
        if (r0 > 0) { pa = bf2f(Pl[(r0 - 1) * 268 + fl]); pb = bf2f(Pl[(r0 - 1) * 268 + 128 + fl]); }
        float ca = bf2f(Pl[r0 * 268 + fl]), cb2 = bf2f(Pl[r0 * 268 + 128 + fl]);
#pragma unroll 4
        for (int rr = r0; rr < r0 + 64; ++rr) {
          float na = 0.f, nb2 = 0.f;
          if (rr + 1 < 256) { na = bf2f(Pl[(rr + 1) * 268 + fl]); nb2 = bf2f(Pl[(rr + 1) * 268 + 128 + fl]); }
          const float ua = wa0 * pa + wa1 * ca + wa2 * na + ba;
          const float ub = wb0 * pb + wb1 * cb2 + wb2 * nb2 + bb;
          const float o = ua / (1.f + __expf(-ua)) * ub;
          if (!((rr == 0 && defer0) || (rr == 255 && defer255))) actp[(size_t)rr * FF] = f2bf(o);
          pa = ca; ca = na; pb = cb2; cb2 = nb2;
        }
        if (tid < 128) {
          const int hr = tid >> 5, ch = tid & 31;
          const int srcrow = hr < 2 ? hr : 252 + hr;
          *(uint4*)(halo + ((size_t)(mt * 22 + nb) * 4 + hr) * 256 + ch * 8) = make_uint4(((const uint2*)(Pl + srcrow * 268 + ch * 8))[0].x, ((const uint2*)(Pl + srcrow * 268 + ch * 8))[0].y, ((const uint2*)(Pl + srcrow * 268 + ch * 8))[1].x, ((const uint2*)(Pl + srcrow * 268 + ch * 8))[1].y);
        }
      }
      __syncthreads();
      continue;
    }
#pragma unroll
    for (int ai = 0; ai < 2; ++ai)
#pragma unroll
      for (int bj = 0; bj < 2; ++bj)
#pragma unroll
        for (int n = 0; n < 2; ++n) {
          const int col = bcol + bj * HALF + wc * 32 + n * 16 + fr;
          if (col < N) {
#pragma unroll
            for (int m = 0; m < 4; ++m)
#pragma unroll
              for (int jj = 0; jj < 4; ++jj) {
                const size_t off = (size_t)(brow + ai * HALF + wr * 64 + m * 16 + fq * 4 + jj) * ldc + col;
                if (epi == 0) ((bf16*)Cv)[off] = f2bf(acc[ai][bj][m][n][jj]);
                else ((float*)Cv)[off] = acc[ai][bj][m][n][jj];
              }
          }
        }
  }
#undef SA
#undef SB
#undef STAGE
#undef LDA
#undef LDB
#undef LDSR
#undef TIE_A
#undef TIE_B
#undef MMA
#undef WAIT_V
#undef WAIT_L
#undef BAR
#undef SCHED
}

DI void phase_dnconv(const Params& P, int wv, int vb, int nvb, int j) {
  const int tid = get_tid(wv), lane = tid & 63;
  const bf16* proj = (const bf16*)(P.ws + OFF_P);
  bf16* Q = (bf16*)(P.ws + OFF_DQ);
  bf16* Kb = (bf16*)(P.ws + OFF_DK);
  bf16* V = (bf16*)(P.ws + OFF_DV);
  const int cb = 4 * tid;
  float w[3][3][4];
#pragma unroll
  for (int sec = 0; sec < 3; ++sec)
#pragma unroll
    for (int k = 0; k < 3; ++k) {
      float4 v = *(const float4*)(P.dn_conv_w + (size_t)j * 9216 + k * 3072 + sec * 1024 + cb);
      w[sec][k][0] = v.x; w[sec][k][1] = v.y; w[sec][k][2] = v.z; w[sec][k][3] = v.w;
    }
  for (int run = vb; run < NTOK / 8; run += nvb) {
    const int row0 = run * 8;
    const int s = seq_of_row(row0), ss = seq_start(s), se = ss + seq_len(s);
    float prev[3][4], cur[3][4], nxt[3][4];
#pragma unroll
    for (int sec = 0; sec < 3; ++sec) {
      uint2 u = make_uint2(0u, 0u);
      if (row0 - 1 >= ss) u = *(const uint2*)(proj + (size_t)(row0 - 1) * DNP + sec * 1024 + cb);
      prev[sec][0] = bflo(u.x); prev[sec][1] = bfhi(u.x); prev[sec][2] = bflo(u.y); prev[sec][3] = bfhi(u.y);
      uint2 v = *(const uint2*)(proj + (size_t)row0 * DNP + sec * 1024 + cb);
      cur[sec][0] = bflo(v.x); cur[sec][1] = bfhi(v.x); cur[sec][2] = bflo(v.y); cur[sec][3] = bfhi(v.y);
    }
#pragma unroll 1
    for (int t = 0; t < 8; ++t) {
      const int row = row0 + t;
#pragma unroll
      for (int sec = 0; sec < 3; ++sec) {
        uint2 u = make_uint2(0u, 0u);
        if (row + 1 < se) u = *(const uint2*)(proj + (size_t)(row + 1) * DNP + sec * 1024 + cb);
        nxt[sec][0] = bflo(u.x); nxt[sec][1] = bfhi(u.x); nxt[sec][2] = bflo(u.y); nxt[sec][3] = bfhi(u.y);
      }
      float val[3][4];
#pragma unroll
      for (int sec = 0; sec < 3; ++sec)
#pragma unroll
        for (int e = 0; e < 4; ++e) {
          float y = w[sec][0][e] * prev[sec][e] + w[sec][1][e] * cur[sec][e] + w[sec][2][e] * nxt[sec][e];
          val[sec][e] = y / (1.f + __expf(-y));
        }
      float sq = val[0][0] * val[0][0] + val[0][1] * val[0][1] + val[0][2] * val[0][2] + val[0][3] * val[0][3];
      float sk = val[1][0] * val[1][0] + val[1][1] * val[1][1] + val[1][2] * val[1][2] + val[1][3] * val[1][3];
#pragma unroll
      for (int o = 16; o > 0; o >>= 1) { sq += shx(sq, o, lane); sk += shx(sk, o, lane); }
      const float rq = rsqrtf(sq + EPS) * 0.08838834764831845f;
      const float rk = rsqrtf(sk + EPS);
      *(uint2*)(Q + (size_t)row * 1024 + cb) = make_uint2(pack2(val[0][0] * rq, val[0][1] * rq), pack2(val[0][2] * rq, val[0][3] * rq));
      *(uint2*)(Kb + (size_t)row * 1024 + cb) = make_uint2(pack2(val[1][0] * rk, val[1][1] * rk), pack2(val[1][2] * rk, val[1][3] * rk));
      *(uint2*)(V + (size_t)row * 1024 + cb) = make_uint2(pack2(val[2][0], val[2][1]), pack2(val[2][2], val[2][3]));
#pragma unroll
      for (int sec = 0; sec < 3; ++sec)
#pragma unroll
        for (int e = 0; e < 4; ++e) { prev[sec][e] = cur[sec][e]; cur[sec][e] = nxt[sec][e]; }
    }
  }
}

DI void phase_dnprep(const Params& P, int wv, int vb, int nvb, int j, char* smem) {
  const int tid0 = get_tid(wv);
  const bf16* proj = (const bf16*)(P.ws + OFF_P);
  const bf16* Q = (const bf16*)(P.ws + OFF_DQ);
  const bf16* Kb = (const bf16*)(P.ws + OFF_DK);
  bf16* QKB = (bf16*)(P.ws + OFF_QK);
  bf16* TB = (bf16*)(P.ws + OFF_TB);
  float* GC = (float*)(P.ws + OFF_GC);
  float* BETA = (float*)(P.ws + OFF_BETA);
  bf16* ksm = (bf16*)smem;
  bf16* qsm = (bf16*)(smem + 17408);
  float* L0 = (float*)(smem + 34816);
  float* L1 = (float*)(smem + 52224);
  float* gcs = (float*)(smem + 69632);
  float* betas = (float*)(smem + 70144);
  for (int it = vb; it < 1536; it += nvb) {
    int tid = tid0;
    asm volatile("" : "+v"(tid));
    const int lane = tid & 63, w = tid >> 6, r = lane & 31, h_ = lane >> 5;
    const int hd = it & 7, gch = it >> 3;
    const int row0 = gch * 64;
    const int s = seq_of_row(row0), ss = seq_start(s), nch = seq_len(s) >> 6;
    const int cn = (row0 - ss) >> 6;
    const int item0 = ((ss / 64 + cn) * 8 + hd) * 2 + 0;
    const int item1 = ((ss / 64 + (nch - 1 - cn)) * 8 + hd) * 2 + 1;
#pragma unroll
    for (int e = 0; e < 4; ++e) {
      const int p = tid + 256 * e, rr = p >> 4, cp = p & 15;
      *(uint4*)(ksm + rr * 136 + cp * 8) = *(const uint4*)(Kb + (size_t)(row0 + rr) * 1024 + hd * 128 + cp * 8);
      *(uint4*)(qsm + rr * 136 + cp * 8) = *(const uint4*)(Q + (size_t)(row0 + rr) * 1024 + hd * 128 + cp * 8);
    }
    if (tid < 128) {
      const int d = tid >> 6, i = tid & 63;
      const int tn = d ? 63 - i : i;
      const size_t row = row0 + tn;
      const float a = bf2f(proj[row * DNP + 4096 + d * 8 + hd]);
      const float b = bf2f(proj[row * DNP + 4112 + d * 8 + hd]);
      const float Aa = __expf(P.dn_a_log[j * 16 + d * 8 + hd]);
      const float xx = a + P.dn_dt_bias[j * 16 + d * 8 + hd];
      const float sp = xx > 20.f ? xx : __logf(1.f + __expf(xx));
      float g = -Aa * sp;
      const float beta = 1.f / (1.f + __expf(-b));
#pragma unroll
      for (int o = 1; o < 64; o <<= 1) { float t = __int_as_float(__builtin_amdgcn_ds_bpermute(((i >= o) ? i - o : i) << 2, __float_as_int(g))); if (i >= o) g += t; }
      gcs[d * 64 + i] = g; betas[d * 64 + i] = beta;
      const int item = d ? item1 : item0;
      GC[item * 64 + i] = g; BETA[item * 64 + i] = beta;
    }
    __syncthreads();
    {
      const int ti = w >> 1, tj = w & 1;
      f32x16 kk, qk;
#pragma unroll
      for (int i = 0; i < 16; ++i) { kk[i] = 0.f; qk[i] = 0.f; }
#pragma unroll
      for (int ks = 0; ks < 8; ++ks) {
        bf16x8 ak = *(const bf16x8*)(ksm + (ti * 32 + r) * 136 + ks * 16 + h_ * 8);
        bf16x8 aq = *(const bf16x8*)(qsm + (ti * 32 + r) * 136 + ks * 16 + h_ * 8);
        bf16x8 bk = *(const bf16x8*)(ksm + (tj * 32 + r) * 136 + ks * 16 + h_ * 8);
        kk = MFMA(ak, bk, kk);
        qk = MFMA(aq, bk, qk);
      }
      __syncthreads();
      bf16* T0 = ksm; bf16* QK0 = ksm + 4096; bf16* T1 = qsm; bf16* QK1 = qsm + 4096;
      (void)T0; (void)T1;
      const int jn = tj * 32 + r;
      const float gj0 = gcs[jn], gj1 = gcs[64 + 63 - jn];
#pragma unroll
      for (int q4 = 0; q4 < 4; ++q4) {
        const int ib = ti * 32 + 8 * q4 + 4 * h_;
#pragma unroll
        for (int e = 0; e < 4; ++e) {
          const int ii = 4 * q4 + e;
          const int i = ib + e;
          {
            const float ex = (i >= jn) ? __expf(gcs[i] - gj0) : 0.f;
            L0[i * 68 + jn] = (i > jn) ? betas[i] * kk[ii] * ex : 0.f;
            QK0[i * 64 + jn] = f2bf(qk[ii] * ex);
          }
          {
            const int is = 63 - i, js = 63 - jn;
            const float ex = (is >= js) ? __expf(gcs[64 + is] - gj1) : 0.f;
            L1[is * 68 + js] = (is > js) ? betas[64 + is] * kk[ii] * ex : 0.f;
            QK1[is * 64 + js] = f2bf(qk[ii] * ex);
          }
          __builtin_amdgcn_sched_barrier(0);
        }
      }
    }
    __syncthreads();
    if (w < 2) {
      const float* L = w ? L1 : L0;
      bf16* TL = w ? qsm : ksm;
      float x[64];
      const float lanef = (float)lane;
#pragma unroll
      for (int i = 0; i < 64; ++i) {
        float a0 = fmaxf(0.f, 1.f - fabsf(lanef - (float)i)), a1 = 0.f, a2 = 0.f, a3 = 0.f;
#pragma unroll
        for (int j4 = 0; j4 < (i + 3) / 4; ++j4) {
          const float4 l = *(const float4*)(L + i * 68 + j4 * 4);
          if (j4 * 4 + 0 < i) a0 -= l.x * x[j4 * 4 + 0];
          if (j4 * 4 + 1 < i) a1 -= l.y * x[j4 * 4 + 1];
          if (j4 * 4 + 2 < i) a2 -= l.z * x[j4 * 4 + 2];
          if (j4 * 4 + 3 < i) a3 -= l.w * x[j4 * 4 + 3];
        }
        const float acc = (a0 + a1) + (a2 + a3);
        x[i] = acc;
        TL[i * 64 + lane] = f2bf(acc);
        __builtin_amdgcn_sched_barrier(0);
      }
    }
    __syncthreads();
#pragma unroll
    for (int e = 0; e < 2; ++e) {
      const int p = tid + 256 * e;
      *(uint4*)(TB + (size_t)item0 * 4096 + p * 8) = *(const uint4*)(ksm + p * 8);
      *(uint4*)(QKB + (size_t)item0 * 4096 + p * 8) = *(const uint4*)(ksm + 4096 + p * 8);
      *(uint4*)(TB + (size_t)item1 * 4096 + p * 8) = *(const uint4*)(qsm + p * 8);
      *(uint4*)(QKB + (size_t)item1 * 4096 + p * 8) = *(const uint4*)(qsm + 4096 + p * 8);
    }
    __syncthreads();
  }
}

#define SC_LDS2(dst, addr, o0) asm volatile("ds_read2_b64 %0, %1 offset0:%2 offset1:%3" : "=v"(dst) : "v"(addr), "n"(o0), "n"((o0) + 2) : "memory")
#define SC_G8(fa, a0, a1, ob) do {                                                                                  \
    SC_LDS2(fa[0], a0, (ob) + 0);  SC_LDS2(fa[1], a1, (ob) + 0);  SC_LDS2(fa[2], a0, (ob) + 4);  SC_LDS2(fa[3], a1, (ob) + 4);  \
    SC_LDS2(fa[4], a0, (ob) + 8);  SC_LDS2(fa[5], a1, (ob) + 8);  SC_LDS2(fa[6], a0, (ob) + 12); SC_LDS2(fa[7], a1, (ob) + 12); } while (0)
#define SC_TIE8(fa) asm volatile("s_waitcnt lgkmcnt(0)" : "+v"(fa[0]), "+v"(fa[1]), "+v"(fa[2]), "+v"(fa[3]), "+v"(fa[4]), "+v"(fa[5]), "+v"(fa[6]), "+v"(fa[7]) :: "memory")
#define SC_G6(fa, a0, a1) do { SC_LDS2(fa[0], a0, 0); SC_LDS2(fa[1], a1, 0); SC_LDS2(fa[2], a0, 4); SC_LDS2(fa[3], a1, 4); \
    SC_LDS2(fa[4], a1, 8); SC_LDS2(fa[5], a1, 12); } while (0)
#define SC_TIE6(fa) asm volatile("s_waitcnt lgkmcnt(0)" : "+v"(fa[0]), "+v"(fa[1]), "+v"(fa[2]), "+v"(fa[3]), "+v"(fa[4]), "+v"(fa[5]) :: "memory")
#define SC_G8T(fa, b0, b1, b2, b3, ob) do {                                                                         \
    SC_LDS2(fa[0], b0, (ob) + 0); SC_LDS2(fa[1], b1, (ob) + 0); SC_LDS2(fa[2], b2, (ob) + 0); SC_LDS2(fa[3], b3, (ob) + 0);     \
    SC_LDS2(fa[4], b0, (ob) + 4); SC_LDS2(fa[5], b1, (ob) + 4); SC_LDS2(fa[6], b2, (ob) + 4); SC_LDS2(fa[7], b3, (ob) + 4); } while (0)
DI void phase_dnscan(const Params& P, int wv, int vb, int nvb, int j, char* smem) {
  const int tid0 = get_tid(wv);
  bf16* obuf = (bf16*)(P.ws + OFF_P);
  const bf16* Q = (const bf16*)(P.ws + OFF_DQ);
  const bf16* Kb = (const bf16*)(P.ws + OFF_DK);
  const bf16* V = (const bf16*)(P.ws + OFF_DV);
  const bf16* QKB = (const bf16*)(P.ws + OFF_QK);
  const bf16* TB = (const bf16*)(P.ws + OFF_TB);
  const float* GC = (const float*)(P.ws + OFF_GC);
  const float* BETA = (const float*)(P.ws + OFF_BETA);
  bf16* ksm = (bf16*)smem;
  bf16* qsm = (bf16*)(smem + 16896);
  bf16* kT = (bf16*)(smem + 33792);
  bf16* Tsm = (bf16*)(smem + 51200);
  bf16* QKsm = (bf16*)(smem + 59904);
  float* egc = (float*)(smem + 68608);
  float* edec = (float*)(smem + 68864);
  float* betas = (float*)(smem + 69120);
  int it0 = vb, it1 = 384, itstep = nvb, lp = 0;
  char* base8 = smem;
  if (nvb >= 512) {
    const int bb = vb >> 1, sb = vb & 1;
    itstep = 1;
    if (bb < 128) { it0 = bb; it1 = bb + 1; lp = sb ? 2 : 1; base8 = smem - sb * LDS_BYTES; }
    else if (bb < 256) { it0 = 128 + 2 * (bb - 128) + sb; it1 = it0 + 1; }
    else { it0 = 0; it1 = 0; }
  }
  for (int it = it0; it < it1; it += itstep) {
    const int w = tid0 >> 6;
    int tidA = tid0;
    asm volatile("" : "+v"(tidA));
    const int dv0 = 32 * w + (tidA & 31), h0_ = (tidA & 63) >> 5;
    int s, rem;
    if (it < 128) { s = 16 + (it >> 4); rem = it & 15; } else { s = (it - 128) >> 4; rem = (it - 128) & 15; }
    const int hd = rem >> 1, d = rem & 1;
    const int ss = seq_start(s), len = seq_len(s), nch = len >> 6, gch0 = ss >> 6;
    f32x16 S[4];
    if (s >= 16 && lp != 2) {
      const float* src = P.state_delta + ((size_t)((((s - 16) * 2 + j) * 2 + d) * 8 + hd)) * 16384;
#pragma unroll
      for (int mt = 0; mt < 4; ++mt)
#pragma unroll
        for (int i = 0; i < 16; ++i) S[mt][i] = src[(32 * mt + crow(i, h0_)) * 128 + dv0];
    } else {
#pragma unroll
      for (int mt = 0; mt < 4; ++mt)
#pragma unroll
        for (int i = 0; i < 16; ++i) S[mt][i] = 0.f;
    }
    const int nsteps = lp ? nch + 1 : nch;
    unsigned vpn[2][8];
#pragma unroll
    for (int tt = 0; tt < 2; ++tt)
#pragma unroll
      for (int e = 0; e < 8; ++e) vpn[tt][e] = 0u;
#pragma unroll 1
    for (int t = 0; t < nsteps; ++t) {
      int tid = tid0;
      asm volatile("" : "+v"(tid));
      const int lane = tid & 63, r = lane & 31, h_ = lane >> 5;
      const int dv = 32 * w + r;
      char* sbL = lp ? base8 + (t & 1) * LDS_BYTES : smem;
      char* sbC = lp ? base8 + ((t + 1) & 1) * LDS_BYTES : smem;
      if (lp != 1 && t < nch) {
        const int cd = t;
        const int item = ((gch0 + cd) * 8 + hd) * 2 + d;
        bf16* ksmL = (bf16*)sbL; bf16* qsmL = (bf16*)(sbL + 16896); bf16* kTL = (bf16*)(sbL + 33792);
        bf16* TsmL = (bf16*)(sbL + 51200); bf16* QKsmL = (bf16*)(sbL + 59904);
        float* egcL = (float*)(sbL + 68608); float* edecL = (float*)(sbL + 68864); float* betasL = (float*)(sbL + 69120);
      uint4 kvr[4], qvr[4], tvr[2], qkr[2];
#pragma unroll
      for (int e = 0; e < 4; ++e) {
        const int p = tid + 256 * e, i = p >> 4, cp = p & 15;
        const int row = ss + (d ? len - 1 - (64 * cd + i) : 64 * cd + i);
        kvr[e] = *(const uint4*)(Kb + (size_t)row * 1024 + hd * 128 + cp * 8);
        qvr[e] = *(const uint4*)(Q + (size_t)row * 1024 + hd * 128 + cp * 8);
      }
#pragma unroll
      for (int e = 0; e < 2; ++e) {
        const int p = tid + 256 * e, i = p >> 3, cp = p & 7;
        tvr[e] = *(const uint4*)(TB + (size_t)item * 4096 + i * 64 + cp * 8);
        qkr[e] = *(const uint4*)(QKB + (size_t)item * 4096 + i * 64 + cp * 8);
      }
      __builtin_amdgcn_sched_barrier(0);
#pragma unroll
      for (int e = 0; e < 4; ++e) {
        const int p = tid + 256 * e, i = p >> 4, cp = p & 15;
        const uint4 kv = kvr[e], qv = qvr[e];
        *(uint2*)(ksmL + i * 132 + cp * 8) = make_uint2(kv.x, kv.y);
        *(uint2*)(ksmL + i * 132 + cp * 8 + 4) = make_uint2(kv.z, kv.w);
        *(uint2*)(qsmL + i * 132 + cp * 8) = make_uint2(qv.x, qv.y);
        *(uint2*)(qsmL + i * 132 + cp * 8 + 4) = make_uint2(qv.z, qv.w);
        bf16* kt = kTL + (cp * 8) * 68 + i;
        kt[0 * 68] = (bf16)(kv.x & 0xffffu); kt[1 * 68] = (bf16)(kv.x >> 16);
        kt[2 * 68] = (bf16)(kv.y & 0xffffu); kt[3 * 68] = (bf16)(kv.y >> 16);
        kt[4 * 68] = (bf16)(kv.z & 0xffffu); kt[5 * 68] = (bf16)(kv.z >> 16);
        kt[6 * 68] = (bf16)(kv.w & 0xffffu); kt[7 * 68] = (bf16)(kv.w >> 16);
      }
#pragma unroll
      for (int e = 0; e < 2; ++e) {
        const int p = tid + 256 * e, i = p >> 3, cp = p & 7;
        const uint4 tv = tvr[e], qv = qkr[e];
        *(uint2*)(TsmL + i * 68 + cp * 8) = make_uint2(tv.x, tv.y);
        *(uint2*)(TsmL + i * 68 + cp * 8 + 4) = make_uint2(tv.z, tv.w);
        *(uint2*)(QKsmL + i * 68 + cp * 8) = make_uint2(qv.x, qv.y);
        *(uint2*)(QKsmL + i * 68 + cp * 8 + 4) = make_uint2(qv.z, qv.w);
      }
      {
        const float glastL_ = GC[item * 64 + 63];
        if (tid < 64) {
          const float gc = GC[item * 64 + tid];
          egcL[tid] = __expf(gc); edecL[tid] = __expf(glastL_ - gc); betasL[tid] = BETA[item * 64 + tid];
        }
      }
      }
      const int cd = lp ? t - 1 : t;
      const bool docomp = (lp != 2) && cd >= 0 && cd < nch;
      unsigned vp[2][8];
#pragma unroll
      for (int tt = 0; tt < 2; ++tt)
#pragma unroll
        for (int e = 0; e < 8; ++e) vp[tt][e] = vpn[tt][e];
      unsigned vlo[16], vhi[16];
      const bool vld = (lp != 2) && t < nch;
      if (vld) {
        const int rsv = d ? -1024 : 1024;
        const int rowbv = ss + (d ? len - 1 - 64 * t : 64 * t);
        const bf16* Vbv = V + (size_t)rowbv * 1024 + hd * 128;
#pragma unroll
        for (int tt = 0; tt < 2; ++tt)
#pragma unroll
          for (int e = 0; e < 8; ++e) {
            const int t0 = 32 * tt + crow(2 * e, h_);
            const bf16* p0 = Vbv + t0 * rsv + dv;
            const bf16* p1 = Vbv + (t0 + 1) * rsv + dv;
            asm volatile("global_load_ushort %0, %1, off" : "=v"(vlo[tt * 8 + e]) : "v"(p0) : "memory");
            asm volatile("global_load_ushort %0, %1, off" : "=v"(vhi[tt * 8 + e]) : "v"(p1) : "memory");
          }
      }
#define V_COLLECT()                                                                                                 \
      do {                                                                                                          \
        asm volatile("s_waitcnt vmcnt(0)" : "+v"(vlo[0]), "+v"(vlo[1]), "+v"(vlo[2]), "+v"(vlo[3]), "+v"(vlo[4]), "+v"(vlo[5]), "+v"(vlo[6]), "+v"(vlo[7]), \
                     "+v"(vlo[8]), "+v"(vlo[9]), "+v"(vlo[10]), "+v"(vlo[11]), "+v"(vlo[12]), "+v"(vlo[13]), "+v"(vlo[14]), "+v"(vlo[15]) :: "memory"); \
        asm volatile("" : "+v"(vhi[0]), "+v"(vhi[1]), "+v"(vhi[2]), "+v"(vhi[3]), "+v"(vhi[4]), "+v"(vhi[5]), "+v"(vhi[6]), "+v"(vhi[7]), \
                     "+v"(vhi[8]), "+v"(vhi[9]), "+v"(vhi[10]), "+v"(vhi[11]), "+v"(vhi[12]), "+v"(vhi[13]), "+v"(vhi[14]), "+v"(vhi[15]) :: "memory"); \
        _Pragma("unroll") for (int k_ = 0; k_ < 16; ++k_) vpn[k_ >> 3][k_ & 7] = vlo[k_] | (vhi[k_] << 16);         \
      } while (0)
      if (!lp) {
        __syncthreads();
        if (vld) {
          V_COLLECT();
#pragma unroll
          for (int tt = 0; tt < 2; ++tt)
#pragma unroll
            for (int e = 0; e < 8; ++e) vp[tt][e] = vpn[tt][e];
        }
      }
      if (docomp) {
        const int item = ((gch0 + cd) * 8 + hd) * 2 + d;
        const bf16* ksmC = (const bf16*)sbC; const bf16* qsmC = (const bf16*)(sbC + 16896); const bf16* kTC = (const bf16*)(sbC + 33792);
        const bf16* TsmC = (const bf16*)(sbC + 51200); const bf16* QKsmC = (const bf16*)(sbC + 59904);
        const float* egcC = (const float*)(sbC + 68608); const float* edecC = (const float*)(sbC + 68864); const float* betasC = (const float*)(sbC + 69120);
        const float eglast = __expf(GC[item * 64 + 63]);
        const int rowb = ss + (d ? len - 1 - 64 * cd : 64 * cd);
        bf16* Ob = obuf + (size_t)rowb * DNP + d * 1024 + hd * 128;
        const int ors = d ? -DNP : DNP;
      f32x16 ks[2];
#pragma unroll
      for (int tt = 0; tt < 2; ++tt)
#pragma unroll
        for (int i = 0; i < 16; ++i) ks[tt][i] = 0.f;
      {
        const unsigned a0 = (unsigned)(size_t)sbC + (unsigned)((r * 132 + 4 * h_) * 2), a1 = a0 + 32 * 132 * 2;
        {
          bf16x8 fa[8];
          SC_G8(fa, a0, a1, 0);
          SC_TIE8(fa);
#pragma unroll
          for (int mt = 0; mt < 2; ++mt)
#pragma unroll
            for (int s2 = 0; s2 < 2; ++s2) {
              const bf16x8 bS = pack8(S[mt], s2);
#pragma unroll
              for (int tt = 0; tt < 2; ++tt) ks[tt] = MFMA(fa[(mt * 2 + s2) * 2 + tt], bS, ks[tt]);
            }
        }
        {
          bf16x8 fb[8];
          SC_G8(fb, a0, a1, 16);
          SC_TIE8(fb);
#pragma unroll
          for (int mt = 0; mt < 2; ++mt)
#pragma unroll
            for (int s2 = 0; s2 < 2; ++s2) {
              const bf16x8 bS = pack8(S[2 + mt], s2);
#pragma unroll
              for (int tt = 0; tt < 2; ++tt) ks[tt] = MFMA(fb[(mt * 2 + s2) * 2 + tt], bS, ks[tt]);
            }
        }
      }
      __builtin_amdgcn_sched_barrier(0);
#pragma unroll
      for (int tt = 0; tt < 2; ++tt)
#pragma unroll
        for (int q4 = 0; q4 < 4; ++q4) {
          const float4 eg = *(const float4*)(egcC + 32 * tt + 8 * q4 + 4 * h_);
          const float4 be = *(const float4*)(betasC + 32 * tt + 8 * q4 + 4 * h_);
          ks[tt][4 * q4 + 0] = be.x * (bflo(vp[tt][2 * q4]) - eg.x * ks[tt][4 * q4 + 0]);
          ks[tt][4 * q4 + 1] = be.y * (bfhi(vp[tt][2 * q4]) - eg.y * ks[tt][4 * q4 + 1]);
          ks[tt][4 * q4 + 2] = be.z * (bflo(vp[tt][2 * q4 + 1]) - eg.z * ks[tt][4 * q4 + 2]);
          ks[tt][4 * q4 + 3] = be.w * (bfhi(vp[tt][2 * q4 + 1]) - eg.w * ks[tt][4 * q4 + 3]);
        }
      __builtin_amdgcn_sched_barrier(0);
      f32x16 vn[2];
#pragma unroll
      for (int tt = 0; tt < 2; ++tt)
#pragma unroll
        for (int i = 0; i < 16; ++i) vn[tt][i] = 0.f;
      {
        bf16x8 fa[6];
        const unsigned a0 = (unsigned)(size_t)sbC + 51200u + (unsigned)((r * 68 + 4 * h_) * 2), a1 = a0 + 32 * 68 * 2;
        SC_G6(fa, a0, a1);
        SC_TIE6(fa);
        const bf16x8 bR00 = pack8(ks[0], 0), bR01 = pack8(ks[0], 1), bR10 = pack8(ks[1], 0), bR11 = pack8(ks[1], 1);
        vn[0] = MFMA(fa[0], bR00, vn[0]); vn[1] = MFMA(fa[1], bR00, vn[1]);
        vn[0] = MFMA(fa[2], bR01, vn[0]); vn[1] = MFMA(fa[3], bR01, vn[1]);
        vn[1] = MFMA(fa[4], bR10, vn[1]); vn[1] = MFMA(fa[5], bR11, vn[1]);
      }
      __builtin_amdgcn_sched_barrier(0);
      f32x16 oa[2];
#pragma unroll
      for (int tt = 0; tt < 2; ++tt)
#pragma unroll
        for (int i = 0; i < 16; ++i) oa[tt][i] = 0.f;
      {
        const unsigned a0 = (unsigned)(size_t)sbC + 16896u + (unsigned)((r * 132 + 4 * h_) * 2), a1 = a0 + 32 * 132 * 2;
        {
          bf16x8 fa[8];
          SC_G8(fa, a0, a1, 0);
          SC_TIE8(fa);
#pragma unroll
          for (int mt = 0; mt < 2; ++mt)
#pragma unroll
            for (int s2 = 0; s2 < 2; ++s2) {
              const bf16x8 bS = pack8(S[mt], s2);
#pragma unroll
              for (int tt = 0; tt < 2; ++tt) oa[tt] = MFMA(fa[(mt * 2 + s2) * 2 + tt], bS, oa[tt]);
            }
        }
        {
          bf16x8 fb[8];
          SC_G8(fb, a0, a1, 16);
          SC_TIE8(fb);
#pragma unroll
          for (int mt = 0; mt < 2; ++mt)
#pragma unroll
            for (int s2 = 0; s2 < 2; ++s2) {
              const bf16x8 bS = pack8(S[2 + mt], s2);
#pragma unroll
              for (int tt = 0; tt < 2; ++tt) oa[tt] = MFMA(fb[(mt * 2 + s2) * 2 + tt], bS, oa[tt]);
            }
        }
      }
#pragma unroll
      for (int tt = 0; tt < 2; ++tt)
#pragma unroll
        for (int q4 = 0; q4 < 4; ++q4) {
          const float4 eg = *(const float4*)(egcC + 32 * tt + 8 * q4 + 4 * h_);
          oa[tt][4 * q4 + 0] *= eg.x; oa[tt][4 * q4 + 1] *= eg.y; oa[tt][4 * q4 + 2] *= eg.z; oa[tt][4 * q4 + 3] *= eg.w;
        }
      {
        bf16x8 fa[6];
        const unsigned a0 = (unsigned)(size_t)sbC + 59904u + (unsigned)((r * 68 + 4 * h_) * 2), a1 = a0 + 32 * 68 * 2;
        SC_G6(fa, a0, a1);
        SC_TIE6(fa);
        const bf16x8 bV00 = pack8(vn[0], 0), bV01 = pack8(vn[0], 1), bV10 = pack8(vn[1], 0), bV11 = pack8(vn[1], 1);
        oa[0] = MFMA(fa[0], bV00, oa[0]); oa[1] = MFMA(fa[1], bV00, oa[1]);
        oa[0] = MFMA(fa[2], bV01, oa[0]); oa[1] = MFMA(fa[3], bV01, oa[1]);
        oa[1] = MFMA(fa[4], bV10, oa[1]); oa[1] = MFMA(fa[5], bV11, oa[1]);
      }
#pragma unroll
      for (int tt = 0; tt < 2; ++tt)
#pragma unroll
        for (int i = 0; i < 16; ++i) {
          const int t = 32 * tt + crow(i, h_);
          Ob[t * ors + dv] = f2bf(oa[tt][i]);
        }
      __builtin_amdgcn_sched_barrier(0);
#pragma unroll
      for (int tt = 0; tt < 2; ++tt)
#pragma unroll
        for (int q4 = 0; q4 < 4; ++q4) {
          const float4 ed = *(const float4*)(edecC + 32 * tt + 8 * q4 + 4 * h_);
          vn[tt][4 * q4 + 0] *= ed.x; vn[tt][4 * q4 + 1] *= ed.y; vn[tt][4 * q4 + 2] *= ed.z; vn[tt][4 * q4 + 3] *= ed.w;
        }
#pragma unroll
      for (int mt = 0; mt < 4; ++mt)
#pragma unroll
        for (int i = 0; i < 16; ++i) S[mt][i] *= eglast;
      {
        const unsigned b0 = (unsigned)(size_t)sbC + 33792u + (unsigned)((r * 68 + 4 * h_) * 2);
        const unsigned b1 = b0 + 32 * 68 * 2, b2 = b0 + 64 * 68 * 2, b3 = b0 + 96 * 68 * 2;
        {
          bf16x8 fa[8];
          SC_G8T(fa, b0, b1, b2, b3, 0);
          SC_TIE8(fa);
#pragma unroll
          for (int s2 = 0; s2 < 2; ++s2) {
            const bf16x8 bV = pack8(vn[0], s2);
#pragma unroll
            for (int mt = 0; mt < 4; ++mt) S[mt] = MFMA(fa[s2 * 4 + mt], bV, S[mt]);
          }
        }
        {
          bf16x8 fb[8];
          SC_G8T(fb, b0, b1, b2, b3, 8);
          SC_TIE8(fb);
#pragma unroll
          for (int s2 = 0; s2 < 2; ++s2) {
            const bf16x8 bV = pack8(vn[1], s2);
#pragma unroll
            for (int mt = 0; mt < 4; ++mt) S[mt] = MFMA(fb[s2 * 4 + mt], bV, S[mt]);
          }
        }
      }
      }
      if (lp == 1 && vld) V_COLLECT();
      __syncthreads();
    }
#undef V_COLLECT
    if (s < 16) {
      int tidB = tid0;
      asm volatile("" : "+v"(tidB));
      const int dv0 = 32 * w + (tidB & 31), h0_ = (tidB & 63) >> 5;
      float* dst = P.out + OUT_STATE + ((size_t)(((s * 2 + j) * 2 + d) * 8 + hd)) * 16384;
#pragma unroll
      for (int mt = 0; mt < 4; ++mt)
#pragma unroll
        for (int i = 0; i < 16; ++i) dst[(32 * mt + crow(i, h0_)) * 128 + dv0] = S[mt][i];
    }
  }
}

DI void phase_dngate(const Params& P, int wv, int vb, int nvb, int j) {
  const int lane = get_tid(wv) & 63, wave = get_tid(wv) >> 6;
  const bf16* proj = (const bf16*)(P.ws + OFF_P);
  bf16* H = (bf16*)(P.ws + OFF_H);
  const int nw = nvb * 4;
  const int c0 = 16 * lane;
  float g[16];
#pragma unroll
  for (int e = 0; e < 16; ++e) g[e] = P.dn_onorm_g[j * 128 + (c0 & 127) + e];
  for (int row = vb * 4 + wave; row < NTOK; row += nw) {
    const bf16* pr = proj + (size_t)row * DNP;
    uint4 a0 = *(const uint4*)(pr + c0), a1 = *(const uint4*)(pr + c0 + 8);
    uint4 b0 = *(const uint4*)(pr + 1024 + c0), b1 = *(const uint4*)(pr + 1024 + c0 + 8);
    uint4 z0 = *(const uint4*)(pr + 3072 + c0), z1 = *(const uint4*)(pr + 3072 + c0 + 8);
    unsigned au[8] = {a0.x, a0.y, a0.z, a0.w, a1.x, a1.y, a1.z, a1.w};
    unsigned bu[8] = {b0.x, b0.y, b0.z, b0.w, b1.x, b1.y, b1.z, b1.w};
    unsigned zu[8] = {z0.x, z0.y, z0.z, z0.w, z1.x, z1.y, z1.z, z1.w};
    float o[16], z[16];
    float ss = 0.f;
#pragma unroll
    for (int e = 0; e < 8; ++e) {
      o[2 * e] = bflo(au[e]) + bflo(bu[e]); o[2 * e + 1] = bfhi(au[e]) + bfhi(bu[e]);
      z[2 * e] = bflo(zu[e]); z[2 * e + 1] = bfhi(zu[e]);
      ss += o[2 * e] * o[2 * e] + o[2 * e + 1] * o[2 * e + 1];
    }
    ss += shx(ss, 1, lane); ss += shx(ss, 2, lane); ss += shx(ss, 4, lane);
    const float rstd = rsqrtf(ss * (1.f / 128.f) + EPS);
    unsigned pk[8];
#pragma unroll
    for (int e = 0; e < 8; ++e) {
      float v0 = o[2 * e] * rstd * g[2 * e] * siluf(z[2 * e]);
      float v1 = o[2 * e + 1] * rstd * g[2 * e + 1] * siluf(z[2 * e + 1]);
      pk[e] = pack2(v0, v1);
    }
    uint4* hp = (uint4*)(H + (size_t)row * 1024 + c0);
    hp[0] = make_uint4(pk[0], pk[1], pk[2], pk[3]);
    hp[1] = make_uint4(pk[4], pk[5], pk[6], pk[7]);
  }
}

DI void phase_atpost(const Params& P, int wv, int vb, int nvb, int j) {
  const int lane = get_tid(wv) & 63, wave = get_tid(wv) >> 6;
  const float* QKV = (const float*)(P.ws + OFF_P);
  bf16* Qb = (bf16*)(P.ws + OFF_AQ);
  bf16* Kb = (bf16*)(P.ws + OFF_AK);
  bf16* VT = (bf16*)(P.ws + OFF_AVT);
  const int nw = nvb * 4;
  const int f = lane & 15, hb = (lane >> 4) & 1;
  const float inv = exp2f(-(float)f * (13.287712379549449f / 16.f));
  for (int row = vb * 4 + wave; row < NTOK; row += nw) {
    const int s = seq_of_row(row), ss = seq_start(s), len = seq_len(s);
    const int t = row - ss;
    const bool smp = row >= NPR;
    const float* src = QKV + (size_t)row * ATP;
    float cs = 1.f, sn = 0.f;
    if (smp) { const float p = (float)(hb ? (t & 63) : (t >> 6)); sincosf(p * inv, &sn, &cs); }
#pragma unroll
    for (int i = 0; i < 8; ++i) {
      const int pi = i * 64 + lane;
      const int c1 = (pi >> 5) * 64 + hb * 32 + f;
      const float x1 = src[c1], x2 = src[c1 + 16];
      const float o1 = x1 * cs - x2 * sn, o2 = x1 * sn + x2 * cs;
      Qb[(size_t)row * 1024 + c1] = f2bf(o1 * 0.125f);
      Qb[(size_t)row * 1024 + c1 + 16] = f2bf(o2 * 0.125f);
    }
#pragma unroll
    for (int i = 0; i < 2; ++i) {
      const int pi = i * 64 + lane;
      const int c1 = (pi >> 5) * 64 + hb * 32 + f;
      const float x1 = src[1024 + c1], x2 = src[1024 + c1 + 16];
      const float o1 = x1 * cs - x2 * sn, o2 = x1 * sn + x2 * cs;
      Kb[(size_t)row * 256 + c1] = f2bf(o1);
      Kb[(size_t)row * 256 + c1 + 16] = f2bf(o2);
      if (!smp) {
        float* ck = P.out + OUT_CK + ((size_t)((s * 2 + j) * 256 + t)) * 256;
        ck[c1] = x1; ck[c1 + 16] = x2;
      }
    }
#pragma unroll
    for (int i = 0; i < 4; ++i) {
      const int cc = i * 64 + lane;
      const float x = src[1280 + cc];
      VT[(size_t)ss * 256 + (size_t)cc * len + t] = f2bf(x);
      if (!smp) P.out[OUT_CV + ((size_t)((s * 2 + j) * 256 + t)) * 256 + cc] = x;
    }
  }
}

DI void phase_attn(const Params& P, int wv, int vb, int nvb, int j, char* smem) {
  const int tid = get_tid(wv), lane = tid & 63, w = (tid >> 6) & 3, r = lane & 31, h_ = lane >> 5;
  const bf16* Qb = (const bf16*)(P.ws + OFF_AQ);
  const bf16* Kb = (const bf16*)(P.ws + OFF_AK);
  const bf16* VT = (const bf16*)(P.ws + OFF_AVT);
  const bf16* Kc = (const bf16*)(P.ws + OFF_KC);
  const bf16* Vct = (const bf16*)(P.ws + OFF_VCT);
  bf16* AO = (bf16*)(P.ws + OFF_H);
  bf16* Ksm = (bf16*)smem;
  bf16* Vsm = (bf16*)(smem + 4608);
  const int lk = tid >> 3, lkc = (tid & 7) * 8;
  const int ld = tid >> 2, ldc = (tid & 3) * 8;
  for (int it = vb; it < 1536; it += nvb) {
    int b, head, qblk; bool smp;
    if (it < 1024) { smp = true; b = it >> 7; head = (it >> 3) & 15; qblk = it & 7; }
    else { const int u = it - 1024; smp = false; b = u >> 5; head = (u >> 1) & 15; qblk = u & 1; }
    const int s = smp ? 16 + b : b, ss = seq_start(s), len = seq_len(s);
    const int kvh = head >> 2;
    const int qb0 = qblk * 128;
    const int q0 = qb0 + w * 32;
    const int qrow = ss + q0 + r;
    bf16x8 bq[4];
#pragma unroll
    for (int ks = 0; ks < 4; ++ks) bq[ks] = *(const bf16x8*)(Qb + (size_t)qrow * 1024 + head * 64 + ks * 16 + h_ * 8);
    float m = P.at_sink[j * 16 + head];
    float l = h_ == 0 ? 1.f : 0.f;
    f32x16 oacc[2];
#pragma unroll
    for (int dt = 0; dt < 2; ++dt)
#pragma unroll
      for (int i = 0; i < 16; ++i) oacc[dt][i] = 0.f;
    const bf16* Kp = Kb + (size_t)ss * 256 + kvh * 64;
    const bf16* VTp = VT + (size_t)ss * 256 + (size_t)kvh * 64 * len;
    const bf16* Kcp = Kc + (size_t)((b * 2 + j) * 4 + kvh) * 512 * 64;
    const bf16* Vcp = Vct + (size_t)((b * 2 + j) * 4 + kvh) * 64 * 512;
    const int klo = smp ? qb0 - 128 : 0;
    const int nloc = smp ? 12 : 8;
    const int ntile = nloc + (smp ? 16 : 0);
    uint4 kreg = make_uint4(0u, 0u, 0u, 0u), vreg = make_uint4(0u, 0u, 0u, 0u);
    if (klo >= 0) {
      kreg = *(const uint4*)(Kp + (size_t)(klo + lk) * 256 + lkc);
      vreg = *(const uint4*)(VTp + (size_t)ld * len + klo + ldc);
    }
    *(uint4*)(Ksm + lk * 72 + lkc) = kreg;
    *(uint2*)(Vsm + ld * 36 + ldc) = make_uint2(vreg.x, vreg.y);
    *(uint2*)(Vsm + ld * 36 + ldc + 4) = make_uint2(vreg.z, vreg.w);
    __syncthreads();
#pragma unroll 1
    for (int t = 0; t < ntile; ++t) {
      const bf16* Kcur = Ksm + (t & 1) * 4608;
      const bf16* Vcur = Vsm + (t & 1) * 4608;
      bool have_next = false;
      if (t + 1 < ntile) {
        const int tn = t + 1;
        if (tn < nloc) {
          const int key0n = klo + tn * 32;
          if (key0n >= 0 && key0n < len) {
            kreg = *(const uint4*)(Kp + (size_t)(key0n + lk) * 256 + lkc);
            vreg = *(const uint4*)(VTp + (size_t)ld * len + key0n + ldc);
            have_next = true;
          }
        } else {
          const int key0n = (tn - nloc) * 32;
          kreg = *(const uint4*)(Kcp + (size_t)(key0n + lk) * 64 + lkc);
          vreg = *(const uint4*)(Vcp + (size_t)ld * 512 + key0n + ldc);
          have_next = true;
        }
      }
      const bool local = t < nloc;
      const int key0 = klo + t * 32;
      const bool skip_empty = local && (key0 < 0 || key0 >= len);
      const bool skip_win = local && smp && (key0 + 31 < q0 - 128 || key0 > q0 + 31 + 128);
      if (!skip_empty && !skip_win) {
      f32x16 sa;
#pragma unroll
      for (int i = 0; i < 16; ++i) sa[i] = 0.f;
#pragma unroll
      for (int ks = 0; ks < 4; ++ks) {
        bf16x8 a = *(const bf16x8*)(Kcur + r * 72 + ks * 16 + h_ * 8);
        sa = MFMA(a, bq[ks], sa);
      }
      if (local && smp && !(key0 >= q0 + 31 - 128 && key0 + 31 <= q0 + 128)) {
        const int qpos = q0 + r;
#pragma unroll
        for (int i = 0; i < 16; ++i) {
          const int dd = qpos - (key0 + crow(i, h_));
          if (dd > 128 || dd < -128) sa[i] = -INFINITY;
        }
      }
      float tmax = sa[0];
#pragma unroll
      for (int i = 1; i < 16; ++i) tmax = fmaxf(tmax, sa[i]);
      tmax = fmaxf(tmax, shx(tmax, 32, lane));
      const float mnew = fmaxf(m, tmax);
      if (__ballot(mnew > m) != 0ull) {
        const float alpha = __expf(m - mnew);
        l *= alpha;
#pragma unroll
        for (int dt = 0; dt < 2; ++dt)
#pragma unroll
          for (int i = 0; i < 16; ++i) oacc[dt][i] *= alpha;
      }
      m = mnew;
      float ls = 0.f;
#pragma unroll
      for (int i = 0; i < 16; ++i) { sa[i] = __expf(sa[i] - mnew); ls += sa[i]; }
      l += ls;
#pragma unroll
      for (int s2 = 0; s2 < 2; ++s2) {
        const bf16x8 bp = pack8(sa, s2);
#pragma unroll
        for (int dt = 0; dt < 2; ++dt) {
          const bf16* ap = Vcur + (32 * dt + r) * 36 + 16 * s2 + 4 * h_;
          oacc[dt] = MFMA(frag2(*(const uint2*)ap, *(const uint2*)(ap + 8)), bp, oacc[dt]);
        }
      }
      }
      if (have_next) {
        bf16* Kn = Ksm + ((t + 1) & 1) * 4608;
        bf16* Vn = Vsm + ((t + 1) & 1) * 4608;
        *(uint4*)(Kn + lk * 72 + lkc) = kreg;
        *(uint2*)(Vn + ld * 36 + ldc) = make_uint2(vreg.x, vreg.y);
        *(uint2*)(Vn + ld * 36 + ldc + 4) = make_uint2(vreg.z, vreg.w);
      }
      __syncthreads();
    }
    l += shx(l, 32, lane);
    const float il = 1.f / l;
#pragma unroll
    for (int dt = 0; dt < 2; ++dt)
#pragma unroll
      for (int q4 = 0; q4 < 4; ++q4) {
        const int dd = 32 * dt + 8 * q4 + 4 * h_;
        *(uint2*)(AO + (size_t)qrow * 1024 + head * 64 + dd) =
            make_uint2(pack2(oacc[dt][4 * q4] * il, oacc[dt][4 * q4 + 1] * il), pack2(oacc[dt][4 * q4 + 2] * il, oacc[dt][4 * q4 + 3] * il));
      }
  }
}

DI void phase_ffnconv(const Params& P, int wv, int vb, int nvb, int layer) {
  const int tid = get_tid(wv);
  const bf16* halo = (const bf16*)(P.ws + OFF_HALO);
  bf16* ACT = (bf16*)(P.ws + OFF_A);
  const float* cw = P.ffn_conv_w + (size_t)layer * 3 * FF2;
  const float* cbv = P.ffn_conv_b + (size_t)layer * FF2;
  const int fl = tid & 127, which = tid >> 7;
  for (int item = vb; item < 24 * 22; item += nvb) {
    const int b = item / 22, nb = item % 22;
    const int sq = b / 3, k = b % 3 + 1;
    const int mtA = 16 + sq * 4 + (k - 1);
    const int R = NPR + sq * 1024 + 256 * k - 1;
    const bf16* HA = halo + (size_t)(mtA * 22 + nb) * 4 * 256;
    const bf16* HB = halo + (size_t)((mtA + 1) * 22 + nb) * 4 * 256;
    const bf16* pp = which ? HA + 3 * 256 : HA + 2 * 256;
    const bf16* pc = which ? HB : HA + 3 * 256;
    const bf16* pn = which ? HB + 256 : HB;
    const int f = nb * 128 + fl;
    const float ua = cw[f] * bf2f(pp[fl]) + cw[FF2 + f] * bf2f(pc[fl]) + cw[2 * FF2 + f] * bf2f(pn[fl]) + cbv[f];
    const float ub = cw[FF + f] * bf2f(pp[128 + fl]) + cw[FF2 + FF + f] * bf2f(pc[128 + fl]) + cw[2 * FF2 + FF + f] * bf2f(pn[128 + fl]) + cbv[FF + f];
    ACT[(size_t)(R + which) * FF + f] = f2bf(ua / (1.f + __expf(-ua)) * ub);
  }
}

DI void run_phase(const Params& P, int wv8, int ph, char* smem8) {
  const int sub = wv8 >> 2, wv = wv8 & 3;
  int vb = (int)blockIdx.x * 2 + sub;
  asm volatile("" : "+s"(vb));
  const int nvb = (int)gridDim.x * 2;
  char* smem = smem8 + sub * LDS_BYTES;
  const float* mod = (const float*)(P.ws + OFF_MOD);
  if (ph == 0) { phase_pre(P, wv, vb, nvb, smem); return; }
  int layer, st;
  if (ph == 1) { layer = -1; st = 0; }
  else if (ph < 13) { layer = 0; st = ph - 2; }
  else if (ph < 21) { layer = 1; st = ph - 13; }
  else if (ph < 32) { layer = 2; st = ph - 21; }
  else { layer = 3; st = ph - 32; }
  const int j = layer >> 1;
  const bool isdn = (layer & 1) == 0;
  int kind;
  int fst;
  if (layer < 0) { kind = 1; fst = -1; }
  else if (isdn) {
    if (st == 0) { kind = 0; fst = -2; } else if (st == 1) { kind = 2; fst = -1; } else if (st == 2) { kind = 3; fst = -1; }
    else if (st == 3) { kind = 4; fst = -1; } else if (st == 4) { kind = 5; fst = -1; } else { fst = st - 5; kind = -1; }
  } else {
    if (st == 0) { kind = 0; fst = -2; } else if (st == 1) { kind = 7; fst = -1; }
    else { fst = st - 2; kind = -1; }
  }
  if (kind < 0) { kind = (fst == 0 || fst == 2 || fst == 4) ? 0 : (fst == 3 ? 8 : 1); }

  if (kind == 0) {
    const bf16* A; int lda; const bf16* Bt; int K, Npad, N; void* C; int ldc, epi;
    const bf16* H = (const bf16*)(P.ws + OFF_H);
    if (fst == -2) {
      A = H; lda = 1024; K = 1024;
      if (isdn) { Bt = (const bf16*)(P.ws + OFF_WIN + j * SZ_WIN); Npad = DNPAD; N = DNP; C = P.ws + OFF_P; ldc = DNP; epi = 0; }
      else { Bt = (const bf16*)(P.ws + OFF_WQKV + j * SZ_WQKV); Npad = ATP; N = ATP; C = P.ws + OFF_P; ldc = ATP; epi = 4; }
    } else if (fst == 0) {
      A = H; lda = 1024; K = 1024; Npad = 1024; N = 1024; C = P.ws + OFF_P; ldc = 1024; epi = 0;
      Bt = isdn ? (const bf16*)(P.ws + OFF_WOUT + j * SZ_WSQ) : (const bf16*)(P.ws + OFF_WO + j * SZ_WSQ);
    } else if (fst == 2) {
      A = H; lda = 1024; K = 1024; Npad = FF2; N = FF2; C = P.ws + OFF_A; ldc = FF; epi = 3;
      Bt = (const bf16*)(P.ws + OFF_WUP + layer * SZ_WUP);
    } else {
      A = (const bf16*)(P.ws + OFF_A); lda = FF; K = FF; Npad = 1024; N = 1024; C = P.ws + OFF_P; ldc = 1024; epi = 0;
      Bt = (const bf16*)(P.ws + OFF_WDN + layer * SZ_WDN);
    }
    phase_gemm(wv8, A, lda, Bt, K, Npad, N, C, ldc, epi, P.ffn_conv_w + (size_t)(layer < 0 ? 0 : layer) * 3 * FF2, P.ffn_conv_b + (size_t)(layer < 0 ? 0 : layer) * FF2, (bf16*)(P.ws + OFF_HALO), P, j < 0 ? 0 : j, smem8);
  } else if (kind == 1) {
    int mode, gate_idx, do_h, shift_idx, scale_idx;
    const float *ga, *modg, *gb, *modn;
    if (layer < 0) {
      mode = 0; ga = P.norm_g; modg = mod; gate_idx = 0; do_h = 1; gb = P.norm_g; modn = mod; shift_idx = 0; scale_idx = 1;
    } else if (fst == 1) {
      mode = 1; ga = P.norm_g + (layer * 4 + 1) * 1024; modg = mod + layer * 9 * 6144; gate_idx = 2;
      do_h = 1; gb = P.norm_g + (layer * 4 + 2) * 1024; modn = modg; shift_idx = 3; scale_idx = 4;
    } else {
      mode = 1; ga = P.norm_g + (layer * 4 + 3) * 1024; modg = mod + layer * 9 * 6144; gate_idx = 5;
      do_h = layer < 3 ? 1 : 0;
      const int nl = layer < 3 ? layer + 1 : 3;
      gb = P.norm_g + (nl * 4 + 0) * 1024; modn = mod + nl * 9 * 6144; shift_idx = 0; scale_idx = 1;
    }
    phase_rowepi(P, wv, vb, nvb, mode, ga, modg, gate_idx, do_h, gb, modn, shift_idx, scale_idx);
  } else if (kind == 2) phase_dnconv(P, wv, vb, nvb, j);
  else if (kind == 3) phase_dnprep(P, wv, vb, nvb, j, smem);
  else if (kind == 4) phase_dnscan(P, wv, vb, nvb, j, smem);
  else if (kind == 5) phase_dngate(P, wv, vb, nvb, j);
  else if (kind == 6) { }
  else if (kind == 7) phase_attn(P, wv, vb, nvb, j, smem);
  else phase_ffnconv(P, wv, vb, nvb, layer);
}


#define XB_TMO      128
#define XB_XCNT(j)  (256  + 64 * (j))
#define XB_XSUB(j)  (1280 + 64 * (j))
#define XB_XGEN(j)  (2304 + 64 * (j))
#define XB_TOP      3328
#define XB_TOPGEN   3392
#define XCD_BAR_WORDS 3456
#define XB_SPIN_CAP (1u << 18)
#define LAS __attribute__((address_space(3)))
DI unsigned xb_ld(unsigned* p) { return __hip_atomic_load(p, __ATOMIC_RELAXED, __HIP_MEMORY_SCOPE_AGENT); }
DI unsigned xb_add(unsigned* p, unsigned v) { return __hip_atomic_fetch_add(p, v, __ATOMIC_RELAXED, __HIP_MEMORY_SCOPE_AGENT); }
DI unsigned xb_xcc_id() { return (unsigned)__builtin_amdgcn_s_getreg((3 << 11) | 20) & 0xFu; }
#define XB_SPIN(cond, bar) do { unsigned _sp = 0; while (cond) { __builtin_amdgcn_s_sleep(1); \
    if ((++_sp & 255u) == 0u) { if (xb_ld(&(bar)[XB_TMO])) break; if (_sp > XB_SPIN_CAP) { atomicAdd(&(bar)[XB_TMO], 1u); break; } } } } while (0)
struct XcdBarrier { unsigned* bar; unsigned x; volatile LAS unsigned* st; };
DI XcdBarrier xcd_barrier_post(unsigned* bar, volatile LAS unsigned* st) {
  XcdBarrier b; b.bar = bar; b.x = xb_xcc_id(); b.st = st;
  if (threadIdx.x == 0) (void)xb_add(&bar[XB_XCNT(b.x)], 1u);
  return b;
}
DI void xcd_barrier_complete(unsigned* bar, unsigned x, unsigned& nloc, unsigned& nx) {
  const unsigned G = gridDim.x * gridDim.y * gridDim.z;
  unsigned sum, cnt, mine, sp = 0u;
  for (;;) {
    sum = 0u; cnt = 0u; mine = 0u;
#pragma unroll
    for (unsigned j = 0; j < 16; ++j) { const unsigned c = xb_ld(&bar[XB_XCNT(j)]); sum += c; cnt += (c > 0u) ? 1u : 0u; mine = (j == x) ? c : mine; }
    if (sum == G) break;
    __builtin_amdgcn_s_sleep(1);
    if ((++sp & 255u) == 0u) { if (xb_ld(&bar[XB_TMO])) break; if (sp > XB_SPIN_CAP) { atomicAdd(&bar[XB_TMO], 1u); break; } }
  }
  nloc = mine > 0u ? mine : 1u; nx = cnt > 0u ? cnt : 1u;
}
DI void xcd_barrier(const XcdBarrier& b, int wv) {
  asm volatile("s_waitcnt vmcnt(0)" ::: "memory");
  __syncthreads();
  if (wv == 0 && lane_id_opaque() == 0) {
    unsigned* bar = b.bar;
    __builtin_amdgcn_s_waitcnt(0);
    unsigned nloc = b.st[0], nx = b.st[1];
    if (nloc == 0u) { xcd_barrier_complete(bar, b.x, nloc, nx); b.st[0] = nloc; b.st[1] = nx; }
    const unsigned old = xb_add(&bar[XB_XSUB(b.x)], 1u);
    const unsigned gen = old / nloc;
    if (old + 1u == (gen + 1u) * nloc) {
      __builtin_amdgcn_fence(__ATOMIC_RELEASE, "agent");
      asm volatile("s_waitcnt vmcnt(0)" ::: "memory");
      const unsigned og = xb_add(&bar[XB_TOP], 1u);
      const unsigned tg = og / nx;
      if (og + 1u == (tg + 1u) * nx) xb_add(&bar[XB_TOPGEN], 1u);
      else XB_SPIN(xb_ld(&bar[XB_TOPGEN]) == tg, bar);
      __builtin_amdgcn_fence(__ATOMIC_ACQUIRE, "agent");
      xb_add(&bar[XB_XGEN(b.x)], 1u);
      asm volatile("s_waitcnt vmcnt(0)" ::: "memory");
    } else {
      XB_SPIN(xb_ld(&bar[XB_XGEN(b.x)]) == gen, bar);
      __builtin_amdgcn_fence(__ATOMIC_ACQUIRE, "agent");
      asm volatile("s_waitcnt vmcnt(0)" ::: "memory");
    }
  }
  __syncthreads();
}
constexpr size_t OFF_BAR = 917504;

#ifndef DUPMASK
#define DUPMASK 0
#endif
DI int phase_kind(int ph) {
  if (ph == 0) return 9;
  if (ph == 1) return 1;
  int st; bool isdn;
  if (ph < 13) { isdn = true; st = ph - 2; } else if (ph < 21) { isdn = false; st = ph - 13; }
  else if (ph < 32) { isdn = true; st = ph - 21; } else { isdn = false; st = ph - 32; }
  int fst;
  if (isdn) { if (st == 0) return 0; if (st <= 4) return st + 1; fst = st - 5; }
  else { if (st == 0) return 0; if (st == 1) return 7; fst = st - 2; }
  return (fst == 0 || fst == 2 || fst == 4) ? 0 : (fst == 3 ? 8 : 1);
}
__global__ void __launch_bounds__(512, 2) mega_kernel(Params P, int p0, int p1) {
  __shared__ __attribute__((aligned(1024))) char smem[2 * LDS_BYTES];
  __shared__ uint4 xb_words;
  const int wv = __builtin_amdgcn_readfirstlane((int)(threadIdx.x >> 6));
  cg::grid_group grid = cg::this_grid();
  if (threadIdx.x == 0) xb_words = make_uint4(0u, 0u, 0u, 0u);
  __syncthreads();
  if (p1 < 0) grid.sync();
  XcdBarrier xb = xcd_barrier_post((unsigned*)(P.ws + OFF_BAR), (volatile LAS unsigned*)&xb_words);
#if DUPMASK
  int ph = p0, q = 0;
  while (ph < p1) {
    run_phase(P, wv, ph, smem);
    const int reps = 1 + ((DUPMASK >> phase_kind(ph)) & 1);
    ++q;
    if (q >= reps) { q = 0; ++ph; }
    if (ph < p1) xcd_barrier(xb, wv);
    if ((DUPMASK >> 10) & 1) xcd_barrier(xb, wv);
  }
#else
  for (int ph = p0; ph < p1; ++ph) {
    run_phase(P, wv, ph, smem);
    if (ph + 1 < p1) xcd_barrier(xb, wv);
    if (ph + 1 < p1) { const int nk = phase_kind(ph + 1); if (nk == 7 || nk == 8 || phase_kind(ph) == 7) xcd_barrier(xb, wv); }
  }
#endif
}

extern "C" void kernel_launch(void* const* d_in, const int* in_sizes, int n_in, void* d_out, int out_size,
                              void* d_ws, size_t ws_size, hipStream_t stream) {
  static int grid_blocks = 0;
  if (!grid_blocks) {
    int dev = 0, cus = 0, per_cu = 0;
    hipGetDevice(&dev);
    hipDeviceGetAttribute(&cus, hipDeviceAttributeMultiprocessorCount, dev);
    hipOccupancyMaxActiveBlocksPerMultiprocessor(&per_cu, mega_kernel, 512, 0);
    if (per_cu > 1) per_cu = 1;
    if (per_cu < 1) per_cu = 1;
    grid_blocks = cus * per_cu;
  }
  if (ws_size < WS_NEEDED) { fprintf(stderr, "workspace too small: %zu < %zu\n", ws_size, (size_t)WS_NEEDED); return; }
  Params p;
  memset(&p, 0, sizeof(p));
  const float** fp = (const float**)&p;
  for (int i = 0; i < 23; ++i) fp[i] = (const float*)d_in[i];
  p.out = (float*)d_out;
  p.ws = (char*)d_ws;
  hipMemsetAsync((char*)d_ws + OFF_BAR, 0, XCD_BAR_WORDS * sizeof(unsigned), stream);
#if MULTI_LAUNCH
  for (int ph = 0; ph < NPH; ++ph) hipLaunchKernelGGL(mega_kernel, dim3(grid_blocks), dim3(512), 0, stream, p, ph, ph + 1);
#else
  int p0 = 0, p1 = NPH;
  void* args[] = {&p, &p0, &p1};
  hipError_t e = hipLaunchCooperativeKernel((void*)mega_kernel, dim3(grid_blocks), dim3(512), args, 0, stream);
  if (e != hipSuccess) fprintf(stderr, "cooperative launch failed: %s (grid %d)\n", hipGetErrorString(e), grid_blocks);
#endif
}
```

```cpp
#include <hip/hip_runtime.h>
#include <hip/hip_cooperative_groups.h>
#include <cstdio>
#include <cstring>
namespace cg = cooperative_groups;

#ifndef MULTI_LAUNCH
#define MULTI_LAUNCH 0
#endif

#define DI __device__ __forceinline__
typedef unsigned short bf16;
using bf16x8 = __attribute__((ext_vector_type(8))) short;
using f32x16 = __attribute__((ext_vector_type(16))) float;
using u32x4 = __attribute__((ext_vector_type(4))) unsigned;
using f32x4n = __attribute__((ext_vector_type(4))) float;
DI float4 nt_load4(const float* p) { const f32x4n v = __builtin_nontemporal_load((const f32x4n*)p); return make_float4(v[0], v[1], v[2], v[3]); }
typedef __bf16 bf16v2 __attribute__((ext_vector_type(2)));
typedef float f32v2 __attribute__((ext_vector_type(2)));
#define MFMA(a, b, c) __builtin_amdgcn_mfma_f32_32x32x16_bf16((a), (b), (c), 0, 0, 0)

DI unsigned pack2(float a, float b) { f32v2 v = {a, b}; bf16v2 r = __builtin_convertvector(v, bf16v2); return __builtin_bit_cast(unsigned, r); }
DI bf16 f2bf(float a) { return (bf16)(pack2(a, 0.f) & 0xffffu); }
DI float bf2f(bf16 b) { return __uint_as_float(((unsigned)b) << 16); }
DI float bflo(unsigned u) { return __uint_as_float(u << 16); }
DI float bfhi(unsigned u) { return __uint_as_float(u & 0xffff0000u); }
DI int crow(int reg, int h) { return (reg & 3) + 8 * (reg >> 2) + 4 * h; }
DI bf16x8 pack8(const f32x16& x, int s) {
  u32x4 p;
  p[0] = pack2(x[8 * s + 0], x[8 * s + 1]); p[1] = pack2(x[8 * s + 2], x[8 * s + 3]);
  p[2] = pack2(x[8 * s + 4], x[8 * s + 5]); p[3] = pack2(x[8 * s + 6], x[8 * s + 7]);
  return __builtin_bit_cast(bf16x8, p);
}
DI bf16x8 frag2(uint2 lo, uint2 hi) { u32x4 p = {lo.x, lo.y, hi.x, hi.y}; return __builtin_bit_cast(bf16x8, p); }
DI int lane_id_opaque() { unsigned z = 0u; asm volatile("" : "+v"(z)); return (int)__builtin_amdgcn_mbcnt_hi(~0u, __builtin_amdgcn_mbcnt_lo(~0u, z)); }
DI int get_tid(int wv) { return (wv << 6) | lane_id_opaque(); }
DI float shx(float v, int mask, int lane) { return __int_as_float(__builtin_amdgcn_ds_bpermute((lane ^ mask) << 2, __float_as_int(v))); }
DI float siluf(float x) { return x / (1.f + __expf(-x)); }

constexpr int DM = 1024, NTOK = 12288, NPR = 4096;
constexpr int DNP = 4128, DNPAD = 4352, FF = 2816, FF2 = 5632, ATP = 1536;
constexpr float EPS = 1e-6f;
DI int seq_of_row(int r) { return r < NPR ? (r >> 8) : 16 + ((r - NPR) >> 10); }
DI int seq_start(int s) { return s < 16 ? s * 256 : NPR + (s - 16) * 1024; }
DI int seq_len(int s) { return s < 16 ? 256 : 1024; }
DI int cond_of_row(int r) { return r < NPR ? 0 : 1 + ((r - NPR) >> 10); }

constexpr size_t OFF_MOD = 0;
constexpr size_t OFF_KC = 1u << 20;
constexpr size_t OFF_VCT = OFF_KC + 4194304;
constexpr size_t OFF_WIN = OFF_VCT + 4194304;
constexpr size_t SZ_WIN = (size_t)DNPAD * 1024 * 2;
constexpr size_t OFF_WOUT = OFF_WIN + 2 * SZ_WIN;
constexpr size_t SZ_WSQ = (size_t)1024 * 1024 * 2;
constexpr size_t OFF_WQKV = OFF_WOUT + 2 * SZ_WSQ;
constexpr size_t SZ_WQKV = (size_t)ATP * 1024 * 2;
constexpr size_t OFF_WO = OFF_WQKV + 2 * SZ_WQKV;
constexpr size_t OFF_WUP = OFF_WO + 2 * SZ_WSQ;
constexpr size_t SZ_WUP = (size_t)FF2 * 1024 * 2;
constexpr size_t OFF_WDN = OFF_WUP + 4 * SZ_WUP;
constexpr size_t SZ_WDN = (size_t)1024 * FF * 2;
constexpr size_t OFF_H = OFF_WDN + 4 * SZ_WDN;
constexpr size_t SZ_TB = (size_t)NTOK * 1024 * 2;
constexpr size_t OFF_P = OFF_H + SZ_TB;
constexpr size_t SZ_P = (size_t)NTOK * FF2 * 2;
constexpr size_t OFF_TB = OFF_P + (size_t)NTOK * DNP * 2;
constexpr size_t OFF_HALO = OFF_P + (64u << 20);
constexpr size_t OFF_A = OFF_P + SZ_P;
constexpr size_t OFF_DQ = OFF_A, OFF_DK = OFF_A + SZ_TB, OFF_DV = OFF_A + 2 * SZ_TB, OFF_QK = OFF_A + 3 * SZ_TB;
constexpr size_t OFF_GC = OFF_A + 4 * SZ_TB, OFF_BETA = OFF_GC + 3072 * 64 * 4;
constexpr size_t OFF_AQ = OFF_A, OFF_AK = OFF_A + SZ_TB, OFF_AVT = OFF_AK + (size_t)NTOK * 256 * 2;
constexpr size_t OFF_XB = OFF_BETA + 3072 * 64 * 4;
constexpr size_t WS_NEEDED = OFF_XB + SZ_TB;
static_assert(OFF_TB + SZ_TB <= OFF_A, "T buffer must fit in P tail");
static_assert(WS_NEEDED <= 402653184ull, "workspace too large");
static_assert((size_t)NTOK * FF * 2 <= WS_NEEDED - OFF_A, "act fits");
constexpr int OUT_STATE = 12582912, OUT_CK = 20971520, OUT_CV = 23068672;

constexpr int LDS_BYTES = 73728;
constexpr int NPH = 40;

struct Params {
  const float *x_prompt, *x_sample, *state_delta, *cache_k, *cache_v, *c, *c_ctx, *w_ada, *b_ada, *norm_g,
      *dn_w_in, *dn_conv_w, *dn_a_log, *dn_dt_bias, *dn_onorm_g, *dn_w_out, *at_w_qkv, *at_sink, *at_w_o,
      *ffn_w_up, *ffn_conv_w, *ffn_conv_b, *ffn_w_down;
  float* out;
  char* ws;
};

DI void phase_pre(const Params& P, int wv, int vb, int nvb, char* smem) {
  const int tid = get_tid(wv), lane = tid & 63, wave = tid >> 6;
  if (vb < 384) {
    float* sc = (float*)smem;
    float* red = (float*)(smem + 36864);
    for (int e = tid; e < 9 * 1024; e += 256) {
      int r = e >> 10, k = e & 1023;
      float v = r == 0 ? P.c_ctx[k] : P.c[(r - 1) * 1024 + k];
      sc[e] = v / (1.f + __expf(-v));
    }
    __syncthreads();
    float* mod = (float*)(P.ws + OFF_MOD);
    for (int tile = vb; tile < 384; tile += nvb) {
      const int l = tile / 96, n0 = (tile % 96) * 64;
      const int c4 = tid & 15, kr = tid >> 4;
      float acc[9][4];
#pragma unroll
      for (int r = 0; r < 9; ++r) { acc[r][0] = acc[r][1] = acc[r][2] = acc[r][3] = 0.f; }
      const float* wp = P.w_ada + (size_t)l * 1024 * 6144 + n0 + c4 * 4;
      for (int k = kr; k < 1024; k += 64) {
        float4 wq[4];
#pragma unroll
        for (int u = 0; u < 4; ++u) wq[u] = nt_load4(wp + (size_t)(k + 16 * u) * 6144);
#pragma unroll
        for (int u = 0; u < 4; ++u)
#pragma unroll
          for (int r = 0; r < 9; ++r) {
            const float s = sc[r * 1024 + k + 16 * u];
            acc[r][0] += s * wq[u].x; acc[r][1] += s * wq[u].y; acc[r][2] += s * wq[u].z; acc[r][3] += s * wq[u].w;
          }
      }
#pragma unroll
      for (int r = 0; r < 9; ++r)
#pragma unroll
        for (int e = 0; e < 4; ++e) {
          float v = acc[r][e];
          v += shx(v, 16, lane); v += shx(v, 32, lane);
          if (lane < 16) red[(wave * 9 + r) * 64 + c4 * 4 + e] = v;
        }
      __syncthreads();
      for (int e = tid; e < 9 * 64; e += 256) {
        int r = e >> 6, cc = e & 63;
        float v = red[(0 * 9 + r) * 64 + cc] + red[(1 * 9 + r) * 64 + cc] + red[(2 * 9 + r) * 64 + cc] + red[(3 * 9 + r) * 64 + cc];
        mod[(l * 9 + r) * 6144 + n0 + cc] = v + P.b_ada[l * 6144 + n0 + cc];
      }
      __syncthreads();
    }
  }
  __syncthreads();
  {
    float* tile = (float*)smem;
    for (int g = vb; g < 3104; g += nvb) {
      const int t = g * 4;
      const float* src; bf16* dst; int K, N, Npad, lt, isup = 0;
      if (t < 2176) { int i = t / 1088; lt = t % 1088; src = P.dn_w_in + (size_t)i * 1024 * DNP; dst = (bf16*)(P.ws + OFF_WIN + i * SZ_WIN); K = 1024; N = DNP; Npad = DNPAD; }
      else if (t < 2688) { int u = t - 2176; int i = u / 256; lt = u % 256; src = P.dn_w_out + (size_t)i * 1024 * 1024; dst = (bf16*)(P.ws + OFF_WOUT + i * SZ_WSQ); K = 1024; N = 1024; Npad = 1024; }
      else if (t < 3456) { int u = t - 2688; int i = u / 384; lt = u % 384; src = P.at_w_qkv + (size_t)i * 1024 * ATP; dst = (bf16*)(P.ws + OFF_WQKV + i * SZ_WQKV); K = 1024; N = ATP; Npad = ATP; }
      else if (t < 3968) { int u = t - 3456; int i = u / 256; lt = u % 256; src = P.at_w_o + (size_t)i * 1024 * 1024; dst = (bf16*)(P.ws + OFF_WO + i * SZ_WSQ); K = 1024; N = 1024; Npad = 1024; }
      else if (t < 9600) { int u = t - 3968; int i = u / 1408; lt = u % 1408; src = P.ffn_w_up + (size_t)i * 1024 * FF2; dst = (bf16*)(P.ws + OFF_WUP + i * SZ_WUP); K = 1024; N = FF2; Npad = FF2; isup = 1; }
      else { int u = t - 9600; int i = u / 704; lt = u % 704; src = P.ffn_w_down + (size_t)i * FF * 1024; dst = (bf16*)(P.ws + OFF_WDN + i * SZ_WDN); K = FF; N = 1024; Npad = 1024; }
      const int NT = Npad / 64;
      const int k0 = (lt / NT) * 64, n00 = (lt % NT) * 64;
      {
        const int r = tid >> 4, c4 = (tid & 15) * 4;
#pragma unroll
        for (int q = 0; q < 4; ++q) {
          const int n0 = n00 + 64 * q;
          const int ns0 = isup ? ((n0 & 255) < 128 ? (n0 >> 8) * 128 + (n0 & 127) : FF + (n0 >> 8) * 128 + (n0 & 127)) : n0;
#pragma unroll
          for (int i = 0; i < 4; ++i) {
            const int k = k0 + r + 16 * i, n = ns0 + c4;
            float4 v = make_float4(0.f, 0.f, 0.f, 0.f);
            if (n < N) v = nt_load4(src + (size_t)k * N + n);
            float* tp = tile + q * 4160 + (r + 16 * i) * 65 + c4;
            tp[0] = v.x; tp[1] = v.y; tp[2] = v.z; tp[3] = v.w;
          }
        }
      }
      __syncthreads();
      {
        const int n = tid >> 2, kq = tid & 3;
#pragma unroll
        for (int q = 0; q < 4; ++q) {
          unsigned pk[8];
#pragma unroll
          for (int e = 0; e < 8; ++e) pk[e] = pack2(tile[q * 4160 + (kq * 16 + 2 * e) * 65 + n], tile[q * 4160 + (kq * 16 + 2 * e + 1) * 65 + n]);
          uint4* dp = (uint4*)(dst + (size_t)(n00 + 64 * q + n) * K + k0 + kq * 16);
          dp[0] = make_uint4(pk[0], pk[1], pk[2], pk[3]);
          dp[1] = make_uint4(pk[4], pk[5], pk[6], pk[7]);
        }
      }
      __syncthreads();
    }
  }
  {
    bf16* Kc = (bf16*)(P.ws + OFF_KC);
    bf16* Vct = (bf16*)(P.ws + OFF_VCT);
    const int nth = nvb * 256;
    for (int idx = vb * 256 + tid; idx < 2097152; idx += nth) {
      {
        int d = idx & 63, s = (idx >> 6) & 511, kvh = (idx >> 15) & 3, bj = idx >> 17;
        Kc[idx] = f2bf(P.cache_k[((bj * 512 + s) * 4 + kvh) * 64 + d]);
      }
      {
        int s = idx & 511, d = (idx >> 9) & 63, kvh = (idx >> 15) & 3, bj = idx >> 17;
        Vct[idx] = f2bf(P.cache_v[((bj * 512 + s) * 4 + kvh) * 64 + d]);
      }
    }
  }
}

DI void phase_rowepi(const Params& P, int wv, int vb, int nvb, int mode, const float* ga, const float* modg, int gate_idx,
                     int do_h, const float* gb, const float* modn, int shift_idx, int scale_idx) {
  const int lane = get_tid(wv) & 63, wave = get_tid(wv) >> 6;
  const bf16* Y = (const bf16*)(P.ws + OFF_P);
  bf16* H = (bf16*)(P.ws + OFF_H);
  bf16* XBp = (bf16*)(P.ws + OFF_XB);
  const int nw = nvb * 4;
  for (int row = vb * 4 + wave; row < NTOK; row += nw) {
    const int c = cond_of_row(row);
    float x[16];
    float* xo = P.out + (size_t)row * 1024;
    if (mode == 0) {
      const float* src = row < NPR ? P.x_prompt + (size_t)row * 1024 : P.x_sample + (size_t)(row - NPR) * 1024;
#pragma unroll
      for (int j = 0; j < 4; ++j) {
        float4 v = *(const float4*)(src + j * 256 + lane * 4);
        x[4 * j] = v.x; x[4 * j + 1] = v.y; x[4 * j + 2] = v.z; x[4 * j + 3] = v.w;
      }
    } else {
      float y[16];
      float ss = 0.f;
#pragma unroll
      for (int j = 0; j < 4; ++j) {
        const uint2 yu = *(const uint2*)(Y + (size_t)row * 1024 + j * 256 + lane * 4);
        float4 v; v.x = bflo(yu.x); v.y = bfhi(yu.x); v.z = bflo(yu.y); v.w = bfhi(yu.y);
        y[4 * j] = v.x; y[4 * j + 1] = v.y; y[4 * j + 2] = v.z; y[4 * j + 3] = v.w;
        ss += v.x * v.x + v.y * v.y + v.z * v.z + v.w * v.w;
        const uint2 xu = *(const uint2*)(XBp + (size_t)row * 1024 + j * 256 + lane * 4);
        x[4 * j] = bflo(xu.x); x[4 * j + 1] = bfhi(xu.x); x[4 * j + 2] = bflo(xu.y); x[4 * j + 3] = bfhi(xu.y);
      }
#pragma unroll
      for (int o = 32; o > 0; o >>= 1) ss += shx(ss, o, lane);
      const float rstd = rsqrtf(ss * (1.f / 1024.f) + EPS);
#pragma unroll
      for (int j = 0; j < 4; ++j) {
        const int col = j * 256 + lane * 4;
        float4 g = *(const float4*)(ga + col);
        float4 gt = *(const float4*)(modg + c * 6144 + gate_idx * 1024 + col);
        x[4 * j] += gt.x * (y[4 * j] * rstd * g.x);
        x[4 * j + 1] += gt.y * (y[4 * j + 1] * rstd * g.y);
        x[4 * j + 2] += gt.z * (y[4 * j + 2] * rstd * g.z);
        x[4 * j + 3] += gt.w * (y[4 * j + 3] * rstd * g.w);
      }
    }
    if (do_h) {
#pragma unroll
      for (int j = 0; j < 4; ++j) *(uint2*)(XBp + (size_t)row * 1024 + j * 256 + lane * 4) = make_uint2(pack2(x[4 * j], x[4 * j + 1]), pack2(x[4 * j + 2], x[4 * j + 3]));
    } else {
#pragma unroll
      for (int j = 0; j < 4; ++j) *(float4*)(xo + j * 256 + lane * 4) = make_float4(x[4 * j], x[4 * j + 1], x[4 * j + 2], x[4 * j + 3]);
    }
    if (do_h) {
      float ss = 0.f;
#pragma unroll
      for (int j = 0; j < 16; ++j) ss += x[j] * x[j];
#pragma unroll
      for (int o = 32; o > 0; o >>= 1) ss += shx(ss, o, lane);
      const float rstd = rsqrtf(ss * (1.f / 1024.f) + EPS);
#pragma unroll
      for (int j = 0; j < 4; ++j) {
        const int col = j * 256 + lane * 4;
        float4 g = *(const float4*)(gb + col);
        float4 sc = *(const float4*)(modn + c * 6144 + scale_idx * 1024 + col);
        float4 sh = *(const float4*)(modn + c * 6144 + shift_idx * 1024 + col);
        float h0 = x[4 * j] * rstd * g.x * (1.f + sc.x) + sh.x;
        float h1 = x[4 * j + 1] * rstd * g.y * (1.f + sc.y) + sh.y;
        float h2 = x[4 * j + 2] * rstd * g.z * (1.f + sc.z) + sh.z;
        float h3 = x[4 * j + 3] * rstd * g.w * (1.f + sc.w) + sh.w;
        *(uint2*)(H + (size_t)row * 1024 + col) = make_uint2(pack2(h0, h1), pack2(h2, h3));
      }
    }
  }
}

#define WAIT_VM(n) asm volatile("s_waitcnt vmcnt(%0)" ::"n"(n) : "memory")
#define RAW_BARRIER() do { asm volatile("s_waitcnt lgkmcnt(0)" ::: "memory"); __builtin_amdgcn_s_barrier(); } while (0)
using f32x4 = __attribute__((ext_vector_type(4))) float;
DI int g8_lds_byte(int r, int c) {
  int st = (r >> 4) * 2 + (c >> 5), rr = r & 15, cc = c & 31, ob = rr * 64 + cc * 2;
  return st * 1024 + (ob ^ (((ob >> 9) & 1) << 5));
}
DI void g8_stage_rc(int b, int& R, int& C) {
  int st = b / 1024, sb = b % 1024, swz = sb ^ (((sb >> 9) & 1) << 5);
  R = (st >> 1) * 16 + swz / 64; C = (st & 1) * 32 + (swz % 64) / 2;
}
DI void phase_gemm(int wv8, const bf16* __restrict__ A, int lda, const bf16* __restrict__ Bt, int K, int Npad, int N,
                   void* Cv, int ldc, int epi, const float* convw, const float* convb, bf16* halo, const Params& P, int jat, char* smem) {
  constexpr int HALF = 128, BK = 64, HT = HALF * BK;
  bf16* shm = (bf16*)smem;
  const int tid = get_tid(wv8) & 511;
  const int wid = tid >> 6, lane = tid & 63, wr = wid >> 2, wc = wid & 3, fr = lane & 15, fq = lane >> 4;
  (void)lda;
  const unsigned g8_ob = (unsigned)(fr * 64 + fq * 16), g8_obs = g8_ob ^ (((g8_ob >> 9) & 1u) << 5);
  const unsigned aA = (unsigned)(size_t)smem + (unsigned)(wr * 8192) + g8_obs;
  const unsigned aB = (unsigned)(size_t)smem + 65536u + (unsigned)(wc * 4096) + g8_obs;
  unsigned voff[2];
#pragma unroll
  for (int i = 0; i < 2; ++i) { int R_, C_; g8_stage_rc(tid * 16 + i * 8192, R_, C_); voff[i] = (unsigned)((R_ * K + C_) * 2); }
#define SA(b, hh) (shm + ((b) * 2 + (hh)) * HT)
#define SB(b, hh) (shm + (4 + (b) * 2 + (hh)) * HT)
#define STAGE(Pp, BASE, br, kt) do { const size_t _gu = (size_t)((BASE) + (long)(br) * K + (long)(kt) * BK);     \
    const char* _gb = (const char*)(((size_t)(unsigned)__builtin_amdgcn_readfirstlane((int)(_gu >> 32)) << 32) |   \
                                    (size_t)(unsigned)__builtin_amdgcn_readfirstlane((int)(unsigned)_gu));     \
    _Pragma("unroll") for (int _i = 0; _i < 2; ++_i)                                                                \
      __builtin_amdgcn_global_load_lds((const unsigned*)(_gb + voff[_i]),                                           \
        (unsigned*)((char*)(Pp) + tid * 16 + _i * 8192), 16, 0, 0); } while (0)
#define LDSR(dst, addr, off) asm volatile("ds_read_b128 %0, %1 offset:%2" : "=v"(dst) : "v"(addr), "n"(off) : "memory")
#define LDA(dst, b, hh) do {                                                                                        \
    LDSR(dst[0][0], aA, ((b) * 2 + (hh)) * 16384 + 0 * 2048 + 0);    LDSR(dst[0][1], aA, ((b) * 2 + (hh)) * 16384 + 0 * 2048 + 1024); \
    LDSR(dst[1][0], aA, ((b) * 2 + (hh)) * 16384 + 1 * 2048 + 0);    LDSR(dst[1][1], aA, ((b) * 2 + (hh)) * 16384 + 1 * 2048 + 1024); \
    LDSR(dst[2][0], aA, ((b) * 2 + (hh)) * 16384 + 2 * 2048 + 0);    LDSR(dst[2][1], aA, ((b) * 2 + (hh)) * 16384 + 2 * 2048 + 1024); \
    LDSR(dst[3][0], aA, ((b) * 2 + (hh)) * 16384 + 3 * 2048 + 0);    LDSR(dst[3][1], aA, ((b) * 2 + (hh)) * 16384 + 3 * 2048 + 1024); } while (0)
#define LDB(dst, b, hh) do {                                                                                        \
    LDSR(dst[0][0], aB, ((b) * 2 + (hh)) * 16384 + 0 * 2048 + 0);    LDSR(dst[0][1], aB, ((b) * 2 + (hh)) * 16384 + 0 * 2048 + 1024); \
    LDSR(dst[1][0], aB, ((b) * 2 + (hh)) * 16384 + 1 * 2048 + 0);    LDSR(dst[1][1], aB, ((b) * 2 + (hh)) * 16384 + 1 * 2048 + 1024); } while (0)
#define TIE_A(x) asm volatile("" : "+v"(x[0][0]), "+v"(x[0][1]), "+v"(x[1][0]), "+v"(x[1][1]), "+v"(x[2][0]), "+v"(x[2][1]), "+v"(x[3][0]), "+v"(x[3][1]) :: "memory")
#define TIE_B(x) asm volatile("" : "+v"(x[0][0]), "+v"(x[0][1]), "+v"(x[1][0]), "+v"(x[1][1]) :: "memory")
#define MMA(ai, bj, At_, Bt_) do { TIE_A(At_); TIE_B(Bt_); __builtin_amdgcn_s_setprio(1);                                                   \
    _Pragma("unroll") for (int m = 0; m < 4; ++m) _Pragma("unroll") for (int n = 0; n < 2; ++n) _Pragma("unroll") for (int k = 0; k < 2; ++k) \
      acc[ai][bj][m][n] = __builtin_amdgcn_mfma_f32_16x16x32_bf16(At_[m][k], Bt_[n][k], acc[ai][bj][m][n], 0, 0, 0); \
    __builtin_amdgcn_s_setprio(0); } while (0)
#define WAIT_V(n) asm volatile("s_waitcnt vmcnt(" #n ")" ::: "memory")
#define WAIT_L(n) asm volatile("s_waitcnt lgkmcnt(" #n ")" ::: "memory")
#define BAR __builtin_amdgcn_s_barrier()
#define SCHED __builtin_amdgcn_sched_barrier(0)
  const int nN = Npad / 256, ntiles = (NTOK / 256) * nN, nt = K / BK;
  for (int tile = blockIdx.x; tile < ntiles; tile += gridDim.x) {
    const int tmt = tile % 48, tnt = tile / 48;
    const int brow = tmt * 256, bcol = tnt * 256;
    f32x4 acc[2][2][4][2];
#pragma unroll
    for (int a = 0; a < 2; ++a)
#pragma unroll
      for (int b = 0; b < 2; ++b)
#pragma unroll
        for (int m = 0; m < 4; ++m)
#pragma unroll
          for (int n = 0; n < 2; ++n) acc[a][b][m][n] = f32x4{0.f, 0.f, 0.f, 0.f};
    bf16x8 At[4][2], B0[2][2], B1[2][2];
    WAIT_V(0);
    STAGE(SB(0, 0), Bt, bcol, 0); STAGE(SA(0, 0), A, brow, 0);
    STAGE(SB(0, 1), Bt, bcol + HALF, 0); STAGE(SA(0, 1), A, brow + HALF, 0);
    if (wr == 1) BAR;
    WAIT_V(4); BAR;
    STAGE(SB(1, 0), Bt, bcol, 1); STAGE(SA(1, 0), A, brow, 1); STAGE(SB(1, 1), Bt, bcol + HALF, 1);
    WAIT_V(6); BAR;
    for (int t = 0; t < nt - 2; t += 2) {
      LDB(B0, 0, 0); SCHED; LDA(At, 0, 0); STAGE(SA(1, 1), A, brow + HALF, t + 1);
      WAIT_L(8); BAR; WAIT_L(0); MMA(0, 0, At, B0); BAR; SCHED;
      LDB(B1, 0, 1); STAGE(SB(0, 0), Bt, bcol, t + 2);
      BAR; WAIT_L(0); MMA(0, 1, At, B1); BAR;
      LDA(At, 0, 1); STAGE(SA(0, 0), A, brow, t + 2);
      BAR; WAIT_L(0); MMA(1, 0, At, B0); BAR; SCHED;
      STAGE(SB(0, 1), Bt, bcol + HALF, t + 2);
      WAIT_V(6); BAR; MMA(1, 1, At, B1); BAR;
      LDB(B0, 1, 0); SCHED; LDA(At, 1, 0); STAGE(SA(0, 1), A, brow + HALF, t + 2);
      WAIT_L(8); BAR; WAIT_L(0); MMA(0, 0, At, B0); BAR; SCHED;
      LDB(B1, 1, 1); STAGE(SB(1, 0), Bt, bcol, t + 3);
      BAR; WAIT_L(0); MMA(0, 1, At, B1); BAR;
      LDA(At, 1, 1); STAGE(SA(1, 0), A, brow, t + 3);
      BAR; WAIT_L(0); MMA(1, 0, At, B0); BAR; SCHED;
      STAGE(SB(1, 1), Bt, bcol + HALF, t + 3);
      WAIT_V(6); BAR; MMA(1, 1, At, B1); BAR;
    }
    { LDB(B0, 0, 0); LDA(At, 0, 0); STAGE(SA(1, 1), A, brow + HALF, nt - 1);
      BAR; WAIT_L(0); MMA(0, 0, At, B0); BAR;
      LDB(B1, 0, 1); BAR; WAIT_L(0); MMA(0, 1, At, B1); BAR;
      LDA(At, 0, 1); WAIT_V(4); BAR; WAIT_L(0); MMA(1, 0, At, B0); MMA(1, 1, At, B1); BAR; }
    { LDB(B0, 1, 0); LDA(At, 1, 0); WAIT_V(2); BAR; WAIT_L(0); MMA(0, 0, At, B0); BAR;
      LDB(B1, 1, 1); WAIT_V(0); BAR; WAIT_L(0); MMA(0, 1, At, B1); BAR;
      LDA(At, 1, 1); BAR; WAIT_L(0); MMA(1, 0, At, B0); MMA(1, 1, At, B1); BAR; }
    if (wr == 0) BAR;
    if (epi >= 3) {
      bf16* Plw = (bf16*)smem;
      int pb = (wr * 64 + fq * 4) * 268 + wc * 32 + fr;
      asm volatile("" : "+v"(pb));
#pragma unroll
      for (int ai = 0; ai < 2; ++ai)
#pragma unroll
        for (int bj = 0; bj < 2; ++bj)
#pragma unroll
          for (int m = 0; m < 4; ++m)
#pragma unroll
            for (int n = 0; n < 2; ++n)
#pragma unroll
              for (int jj = 0; jj < 4; ++jj)
                Plw[pb + (ai * HALF + m * 16 + jj) * 268 + bj * HALF + n * 16] = f2bf(acc[ai][bj][m][n][jj]);
      __syncthreads();
    }
    if (epi == 4) {
      bf16* Pl = (bf16*)smem;
      const int nb = tnt, mt = tmt;
      {
        int tidq = tid;
        asm volatile("" : "+v"(tidq));
        const bool smp = mt >= 16;
        const int sq = smp ? 16 + ((mt - 16) >> 2) : mt;
        const int ssq = seq_start(sq), lenq = seq_len(sq);
        const int tb = brow - ssq;
        if (nb < 5) {
          const int row = tidq >> 1, hsel = tidq & 1;
          const int tpos = tb + row;
          const float scl = nb < 4 ? 0.125f : 1.f;
#pragma unroll 1
          for (int hh = 0; hh < 4; ++hh) {
            const int hl = hh >> 1, hb = hh & 1;
            const int colh = hsel * 128 + hl * 64 + hb * 32;
            const bf16* src = Pl + row * 268 + colh;
            float v[32];
#pragma unroll
            for (int c8 = 0; c8 < 4; ++c8) {
              const uint2 ua_ = *(const uint2*)(src + c8 * 8), ub_ = *(const uint2*)(src + c8 * 8 + 4);
              const uint4 u = make_uint4(ua_.x, ua_.y, ub_.x, ub_.y);
              v[c8 * 8 + 0] = bflo(u.x); v[c8 * 8 + 1] = bfhi(u.x); v[c8 * 8 + 2] = bflo(u.y); v[c8 * 8 + 3] = bfhi(u.y);
              v[c8 * 8 + 4] = bflo(u.z); v[c8 * 8 + 5] = bfhi(u.z); v[c8 * 8 + 6] = bflo(u.w); v[c8 * 8 + 7] = bfhi(u.w);
            }
            if (nb == 4 && !smp) {
              float* ck = P.out + OUT_CK + ((size_t)((sq * 2 + jat) * 256 + tpos)) * 256 + colh;
#pragma unroll
              for (int c4 = 0; c4 < 8; ++c4) *(float4*)(ck + c4 * 4) = make_float4(v[c4 * 4], v[c4 * 4 + 1], v[c4 * 4 + 2], v[c4 * 4 + 3]);
            }
            float o[32];
            const float pp = (float)(hb ? (tpos & 63) : (tpos >> 6));
#pragma unroll
            for (int f = 0; f < 16; ++f) {
              float c_ = 1.f, s_ = 0.f;
              if (smp) { const float ang = pp * exp2f(-(float)f * (13.287712379549449f / 16.f)); c_ = __cosf(ang); s_ = __sinf(ang); }
              const float x1 = v[f], x2 = v[16 + f];
              o[f] = x1 * c_ - x2 * s_;
              o[16 + f] = x1 * s_ + x2 * c_;
            }
            bf16* dst = nb < 4 ? (bf16*)(P.ws + OFF_AQ) + (size_t)(brow + row) * 1024 + nb * 256 + colh
                               : (bf16*)(P.ws + OFF_AK) + (size_t)(brow + row) * 256 + colh;
#pragma unroll
            for (int c8 = 0; c8 < 4; ++c8)
              *(uint4*)(dst + c8 * 8) = make_uint4(pack2(o[c8 * 8] * scl, o[c8 * 8 + 1] * scl), pack2(o[c8 * 8 + 2] * scl, o[c8 * 8 + 3] * scl),
                                                   pack2(o[c8 * 8 + 4] * scl, o[c8 * 8 + 5] * scl), pack2(o[c8 * 8 + 6] * scl, o[c8 * 8 + 7] * scl));
          }
        } else {
          const int c = tidq & 255, rh = tidq >> 8;
          bf16* vt = (bf16*)(P.ws + OFF_AVT) + (size_t)ssq * 256 + (size_t)c * lenq + tb + rh * 128;
#pragma unroll 4
          for (int g8 = 0; g8 < 16; ++g8) {
            unsigned short e[8];
#pragma unroll
            for (int q = 0; q < 8; ++q) e[q] = Pl[(rh * 128 + g8 * 8 + q) * 268 + c];
            *(uint4*)(vt + g8 * 8) = make_uint4((unsigned)e[0] | ((unsigned)e[1] << 16), (unsigned)e[2] | ((unsigned)e[3] << 16),
                                                 (unsigned)e[4] | ((unsigned)e[5] << 16), (unsigned)e[6] | ((unsigned)e[7] << 16));
          }
          if (!smp) {
            const int row = tidq >> 1, hsel = tidq & 1;
            float* cv = P.out + OUT_CV + ((size_t)((sq * 2 + jat) * 256 + tb + row)) * 256 + hsel * 128;
            const bf16* src = Pl + row * 268 + hsel * 128;
#pragma unroll 4
            for (int c8 = 0; c8 < 16; ++c8) {
              const uint2 ua_ = *(const uint2*)(src + c8 * 8), ub_ = *(const uint2*)(src + c8 * 8 + 4);
              const uint4 u = make_uint4(ua_.x, ua_.y, ub_.x, ub_.y);
              *(float4*)(cv + c8 * 8) = make_float4(bflo(u.x), bfhi(u.x), bflo(u.y), bfhi(u.y));
              *(float4*)(cv + c8 * 8 + 4) = make_float4(bflo(u.z), bfhi(u.z), bflo(u.w), bfhi(u.w));
            }
          }
        }
      }
      __syncthreads();
      continue;
    }
    if (epi == 3) {
      bf16* Pl = (bf16*)smem;
      const int nb = tnt, mt = tmt;
      {
        const int fl = tid & 127, strip = tid >> 7, r0 = strip * 64;
        const int f = nb * 128 + fl;
        const float* cw = (const float*)convw;
        const float* cbv = (const float*)convb;
        const float wa0 = cw[f], wa1 = cw[FF2 + f], wa2 = cw[2 * FF2 + f], ba = cbv[f];
        const float wb0 = cw[FF + f], wb1 = cw[FF2 + FF + f], wb2 = cw[2 * FF2 + FF + f], bb = cbv[FF + f];
        const bool smp = mt >= 16;
        const int qd = (mt - 16) & 3;
        const bool defer0 = smp && qd != 0, defer255 = smp && qd != 3;
        bf16* actp = (bf16*)Cv + (size_t)brow * FF + f;
        float pa = 0.f, pb = 0.f;
        if (r0 > 0) { pa = bf2f(Pl[(r0 - 1) * 268 + fl]); pb = bf2f(Pl[(r0 - 1) * 268 + 128 + fl]); }
        float ca = bf2f(Pl[r0 * 268 + fl]), cb2 = bf2f(Pl[r0 * 268 + 128 + fl]);
#pragma unroll 4
        for (int rr = r0; rr < r0 + 64; ++rr) {
          float na = 0.f, nb2 = 0.f;
          if (rr + 1 < 256) { na = bf2f(Pl[(rr + 1) * 268 + fl]); nb2 = bf2f(Pl[(rr + 1) * 268 + 128 + fl]); }
          const float ua = wa0 * pa + wa1 * ca + wa2 * na + ba;
          const float ub = wb0 * pb + wb1 * cb2 + wb2 * nb2 + bb;
          const float o = ua / (1.f + __expf(-ua)) * ub;
          if (!((rr == 0 && defer0) || (rr == 255 && defer255))) actp[(size_t)rr * FF] = f2bf(o);
          pa = ca; ca = na; pb = cb2; cb2 = nb2;
        }
        if (tid < 128) {
          const int hr = tid >> 5, ch = tid & 31;
          const int srcrow = hr < 2 ? hr : 252 + hr;
          *(uint4*)(halo + ((size_t)(mt * 22 + nb) * 4 + hr) * 256 + ch * 8) = make_uint4(((const uint2*)(Pl + srcrow * 268 + ch * 8))[0].x, ((const uint2*)(Pl + srcrow * 268 + ch * 8))[0].y, ((const uint2*)(Pl + srcrow * 268 + ch * 8))[1].x, ((const uint2*)(Pl + srcrow * 268 + ch * 8))[1].y);
        }
      }
      __syncthreads();
      continue;
    }
#pragma unroll
    for (int ai = 0; ai < 2; ++ai)
#pragma unroll
      for (int bj = 0; bj < 2; ++bj)
#pragma unroll
        for (int n = 0; n < 2; ++n) {
          const int col = bcol + bj * HALF + wc * 32 + n * 16 + fr;
          if (col < N) {
#pragma unroll
            for (int m = 0; m < 4; ++m)
#pragma unroll
              for (int jj = 0; jj < 4; ++jj) {
                const size_t off = (size_t)(brow + ai * HALF + wr * 64 + m * 16 + fq * 4 + jj) * ldc + col;
                if (epi == 0) ((bf16*)Cv)[off] = f2bf(acc[ai][bj][m][n][jj]);
                else ((float*)Cv)[off] = acc[ai][bj][m][n][jj];
              }
          }
        }
  }
#undef SA
#undef SB
#undef STAGE
#undef LDA
#undef LDB
#undef LDSR
#undef TIE_A
#undef TIE_B
#undef MMA
#undef WAIT_V
#undef WAIT_L
#undef BAR
#undef SCHED
}

DI void phase_dnconv(const Params& P, int wv, int vb, int nvb, int j) {
  const int tid = get_tid(wv), lane = tid & 63;
  const bf16* proj = (const bf16*)(P.ws + OFF_P);
  bf16* Q = (bf16*)(P.ws + OFF_DQ);
  bf16* Kb = (bf16*)(P.ws + OFF_DK);
  bf16* V = (bf16*)(P.ws + OFF_DV);
  const int cb = 4 * tid;
  float w[3][3][4];
#pragma unroll
  for (int sec = 0; sec < 3; ++sec)
#pragma unroll
    for (int k = 0; k < 3; ++k) {
      float4 v = *(const float4*)(P.dn_conv_w + (size_t)j * 9216 + k * 3072 + sec * 1024 + cb);
      w[sec][k][0] = v.x; w[sec][k][1] = v.y; w[sec][k][2] = v.z; w[sec][k][3] = v.w;
    }
  for (int run = vb; run < NTOK / 8; run += nvb) {
    const int row0 = run * 8;
    const int s = seq_of_row(row0), ss = seq_start(s), se = ss + seq_len(s);
    float prev[3][4], cur[3][4], nxt[3][4];
#pragma unroll
    for (int sec = 0; sec < 3; ++sec) {
      uint2 u = make_uint2(0u, 0u);
      if (row0 - 1 >= ss) u = *(const uint2*)(proj + (size_t)(row0 - 1) * DNP + sec * 1024 + cb);
      prev[sec][0] = bflo(u.x); prev[sec][1] = bfhi(u.x); prev[sec][2] = bflo(u.y); prev[sec][3] = bfhi(u.y);
      uint2 v = *(const uint2*)(proj + (size_t)row0 * DNP + sec * 1024 + cb);
      cur[sec][0] = bflo(v.x); cur[sec][1] = bfhi(v.x); cur[sec][2] = bflo(v.y); cur[sec][3] = bfhi(v.y);
    }
#pragma unroll 1
    for (int t = 0; t < 8; ++t) {
      const int row = row0 + t;
#pragma unroll
      for (int sec = 0; sec < 3; ++sec) {
        uint2 u = make_uint2(0u, 0u);
        if (row + 1 < se) u = *(const uint2*)(proj + (size_t)(row + 1) * DNP + sec * 1024 + cb);
        nxt[sec][0] = bflo(u.x); nxt[sec][1] = bfhi(u.x); nxt[sec][2] = bflo(u.y); nxt[sec][3] = bfhi(u.y);
      }
      float val[3][4];
#pragma unroll
      for (int sec = 0; sec < 3; ++sec)
#pragma unroll
        for (int e = 0; e < 4; ++e) {
          float y = w[sec][0][e] * prev[sec][e] + w[sec][1][e] * cur[sec][e] + w[sec][2][e] * nxt[sec][e];
          val[sec][e] = y / (1.f + __expf(-y));
        }
      float sq = val[0][0] * val[0][0] + val[0][1] * val[0][1] + val[0][2] * val[0][2] + val[0][3] * val[0][3];
      float sk = val[1][0] * val[1][0] + val[1][1] * val[1][1] + val[1][2] * val[1][2] + val[1][3] * val[1][3];
#pragma unroll
      for (int o = 16; o > 0; o >>= 1) { sq += shx(sq, o, lane); sk += shx(sk, o, lane); }
      const float rq = rsqrtf(sq + EPS) * 0.08838834764831845f;
      const float rk = rsqrtf(sk + EPS);
      *(uint2*)(Q + (size_t)row * 1024 + cb) = make_uint2(pack2(val[0][0] * rq, val[0][1] * rq), pack2(val[0][2] * rq, val[0][3] * rq));
      *(uint2*)(Kb + (size_t)row * 1024 + cb) = make_uint2(pack2(val[1][0] * rk, val[1][1] * rk), pack2(val[1][2] * rk, val[1][3] * rk));
      *(uint2*)(V + (size_t)row * 1024 + cb) = make_uint2(pack2(val[2][0], val[2][1]), pack2(val[2][2], val[2][3]));
#pragma unroll
      for (int sec = 0; sec < 3; ++sec)
#pragma unroll
        for (int e = 0; e < 4; ++e) { prev[sec][e] = cur[sec][e]; cur[sec][e] = nxt[sec][e]; }
    }
  }
}

DI void phase_dnprep(const Params& P, int wv, int vb, int nvb, int j, char* smem) {
  const int tid0 = get_tid(wv);
  const bf16* proj = (const bf16*)(P.ws + OFF_P);
  const bf16* Q = (const bf16*)(P.ws + OFF_DQ);
  const bf16* Kb = (const bf16*)(P.ws + OFF_DK);
  bf16* QKB = (bf16*)(P.ws + OFF_QK);
  bf16* TB = (bf16*)(P.ws + OFF_TB);
  float* GC = (float*)(P.ws + OFF_GC);
  float* BETA = (float*)(P.ws + OFF_BETA);
  bf16* ksm = (bf16*)smem;
  bf16* qsm = (bf16*)(smem + 17408);
  float* L0 = (float*)(smem + 34816);
  float* L1 = (float*)(smem + 52224);
  float* gcs = (float*)(smem + 69632);
  float* betas = (float*)(smem + 70144);
  for (int it = vb; it < 1536; it += nvb) {
    int tid = tid0;
    asm volatile("" : "+v"(tid));
    const int lane = tid & 63, w = tid >> 6, r = lane & 31, h_ = lane >> 5;
    const int hd = it & 7, gch = it >> 3;
    const int row0 = gch * 64;
    const int s = seq_of_row(row0), ss = seq_start(s), nch = seq_len(s) >> 6;
    const int cn = (row0 - ss) >> 6;
    const int item0 = ((ss / 64 + cn) * 8 + hd) * 2 + 0;
    const int item1 = ((ss / 64 + (nch - 1 - cn)) * 8 + hd) * 2 + 1;
#pragma unroll
    for (int e = 0; e < 4; ++e) {
      const int p = tid + 256 * e, rr = p >> 4, cp = p & 15;
      *(uint4*)(ksm + rr * 136 + cp * 8) = *(const uint4*)(Kb + (size_t)(row0 + rr) * 1024 + hd * 128 + cp * 8);
      *(uint4*)(qsm + rr * 136 + cp * 8) = *(const uint4*)(Q + (size_t)(row0 + rr) * 1024 + hd * 128 + cp * 8);
    }
    if (tid < 128) {
      const int d = tid >> 6, i = tid & 63;
      const int tn = d ? 63 - i : i;
      const size_t row = row0 + tn;
      const float a = bf2f(proj[row * DNP + 4096 + d * 8 + hd]);
      const float b = bf2f(proj[row * DNP + 4112 + d * 8 + hd]);
      const float Aa = __expf(P.dn_a_log[j * 16 + d * 8 + hd]);
      const float xx = a + P.dn_dt_bias[j * 16 + d * 8 + hd];
      const float sp = xx > 20.f ? xx : __logf(1.f + __expf(xx));
      float g = -Aa * sp;
      const float beta = 1.f / (1.f + __expf(-b));
#pragma unroll
      for (int o = 1; o < 64; o <<= 1) { float t = __int_as_float(__builtin_amdgcn_ds_bpermute(((i >= o) ? i - o : i) << 2, __float_as_int(g))); if (i >= o) g += t; }
      gcs[d * 64 + i] = g; betas[d * 64 + i] = beta;
      const int item = d ? item1 : item0;
      GC[item * 64 + i] = g; BETA[item * 64 + i] = beta;
    }
    __syncthreads();
    {
      const int ti = w >> 1, tj = w & 1;
      f32x16 kk, qk;
#pragma unroll
      for (int i = 0; i < 16; ++i) { kk[i] = 0.f; qk[i] = 0.f; }
#pragma unroll
      for (int ks = 0; ks < 8; ++ks) {
        bf16x8 ak = *(const bf16x8*)(ksm + (ti * 32 + r) * 136 + ks * 16 + h_ * 8);
        bf16x8 aq = *(const bf16x8*)(qsm + (ti * 32 + r) * 136 + ks * 16 + h_ * 8);
        bf16x8 bk = *(const bf16x8*)(ksm + (tj * 32 + r) * 136 + ks * 16 + h_ * 8);
        kk = MFMA(ak, bk, kk);
        qk = MFMA(aq, bk, qk);
      }
      __syncthreads();
      bf16* T0 = ksm; bf16* QK0 = ksm + 4096; bf16* T1 = qsm; bf16* QK1 = qsm + 4096;
      (void)T0; (void)T1;
      const int jn = tj * 32 + r;
      const float gj0 = gcs[jn], gj1 = gcs[64 + 63 - jn];
#pragma unroll
      for (int q4 = 0; q4 < 4; ++q4) {
        const int ib = ti * 32 + 8 * q4 + 4 * h_;
#pragma unroll
        for (int e = 0; e < 4; ++e) {
          const int ii = 4 * q4 + e;
          const int i = ib + e;
          {
            const float ex = (i >= jn) ? __expf(gcs[i] - gj0) : 0.f;
            L0[i * 68 + jn] = (i > jn) ? betas[i] * kk[ii] * ex : 0.f;
            QK0[i * 64 + jn] = f2bf(qk[ii] * ex);
          }
          {
            const int is = 63 - i, js = 63 - jn;
            const float ex = (is >= js) ? __expf(gcs[64 + is] - gj1) : 0.f;
            L1[is * 68 + js] = (is > js) ? betas[64 + is] * kk[ii] * ex : 0.f;
            QK1[is * 64 + js] = f2bf(qk[ii] * ex);
          }
          __builtin_amdgcn_sched_barrier(0);
        }
      }
    }
    __syncthreads();
    if (w < 2) {
      const float* L = w ? L1 : L0;
      bf16* TL = w ? qsm : ksm;
      float x[64];
      const float lanef = (float)lane;
#pragma unroll
      for (int i = 0; i < 64; ++i) {
        float a0 = fmaxf(0.f, 1.f - fabsf(lanef - (float)i)), a1 = 0.f, a2 = 0.f, a3 = 0.f;
#pragma unroll
        for (int j4 = 0; j4 < (i + 3) / 4; ++j4) {
          const float4 l = *(const float4*)(L + i * 68 + j4 * 4);
          if (j4 * 4 + 0 < i) a0 -= l.x * x[j4 * 4 + 0];
          if (j4 * 4 + 1 < i) a1 -= l.y * x[j4 * 4 + 1];
          if (j4 * 4 + 2 < i) a2 -= l.z * x[j4 * 4 + 2];
          if (j4 * 4 + 3 < i) a3 -= l.w * x[j4 * 4 + 3];
        }
        const float acc = (a0 + a1) + (a2 + a3);
        x[i] = acc;
        TL[i * 64 + lane] = f2bf(acc);
        __builtin_amdgcn_sched_barrier(0);
      }
    }
    __syncthreads();
#pragma unroll
    for (int e = 0; e < 2; ++e) {
      const int p = tid + 256 * e;
      *(uint4*)(TB + (size_t)item0 * 4096 + p * 8) = *(const uint4*)(ksm + p * 8);
      *(uint4*)(QKB + (size_t)item0 * 4096 + p * 8) = *(const uint4*)(ksm + 4096 + p * 8);
      *(uint4*)(TB + (size_t)item1 * 4096 + p * 8) = *(const uint4*)(qsm + p * 8);
      *(uint4*)(QKB + (size_t)item1 * 4096 + p * 8) = *(const uint4*)(qsm + 4096 + p * 8);
    }
    __syncthreads();
  }
}

#define SC_LDS2(dst, addr, o0) asm volatile("ds_read2_b64 %0, %1 offset0:%2 offset1:%3" : "=v"(dst) : "v"(addr), "n"(o0), "n"((o0) + 2) : "memory")
#define SC_G8(fa, a0, a1, ob) do {                                                                                  \
    SC_LDS2(fa[0], a0, (ob) + 0);  SC_LDS2(fa[1], a1, (ob) + 0);  SC_LDS2(fa[2], a0, (ob) + 4);  SC_LDS2(fa[3], a1, (ob) + 4);  \
    SC_LDS2(fa[4], a0, (ob) + 8);  SC_LDS2(fa[5], a1, (ob) + 8);  SC_LDS2(fa[6], a0, (ob) + 12); SC_LDS2(fa[7], a1, (ob) + 12); } while (0)
#define SC_TIE8(fa) asm volatile("s_waitcnt lgkmcnt(0)" : "+v"(fa[0]), "+v"(fa[1]), "+v"(fa[2]), "+v"(fa[3]), "+v"(fa[4]), "+v"(fa[5]), "+v"(fa[6]), "+v"(fa[7]) :: "memory")
#define SC_G6(fa, a0, a1) do { SC_LDS2(fa[0], a0, 0); SC_LDS2(fa[1], a1, 0); SC_LDS2(fa[2], a0, 4); SC_LDS2(fa[3], a1, 4); \
    SC_LDS2(fa[4], a1, 8); SC_LDS2(fa[5], a1, 12); } while (0)
#define SC_TIE6(fa) asm volatile("s_waitcnt lgkmcnt(0)" : "+v"(fa[0]), "+v"(fa[1]), "+v"(fa[2]), "+v"(fa[3]), "+v"(fa[4]), "+v"(fa[5]) :: "memory")
#define SC_G8T(fa, b0, b1, b2, b3, ob) do {                                                                         \
    SC_LDS2(fa[0], b0, (ob) + 0); SC_LDS2(fa[1], b1, (ob) + 0); SC_LDS2(fa[2], b2, (ob) + 0); SC_LDS2(fa[3], b3, (ob) + 0);     \
    SC_LDS2(fa[4], b0, (ob) + 4); SC_LDS2(fa[5], b1, (ob) + 4); SC_LDS2(fa[6], b2, (ob) + 4); SC_LDS2(fa[7], b3, (ob) + 4); } while (0)
DI void phase_dnscan(const Params& P, int wv, int vb, int nvb, int j, char* smem) {
  const int tid0 = get_tid(wv);
  bf16* obuf = (bf16*)(P.ws + OFF_P);
  const bf16* Q = (const bf16*)(P.ws + OFF_DQ);
  const bf16* Kb = (const bf16*)(P.ws + OFF_DK);
  const bf16* V = (const bf16*)(P.ws + OFF_DV);
  const bf16* QKB = (const bf16*)(P.ws + OFF_QK);
  const bf16* TB = (const bf16*)(P.ws + OFF_TB);
  const float* GC = (const float*)(P.ws + OFF_GC);
  const float* BETA = (const float*)(P.ws + OFF_BETA);
  bf16* ksm = (bf16*)smem;
  bf16* qsm = (bf16*)(smem + 16896);
  bf16* kT = (bf16*)(smem + 33792);
  bf16* Tsm = (bf16*)(smem + 51200);
  bf16* QKsm = (bf16*)(smem + 59904);
  float* egc = (float*)(smem + 68608);
  float* edec = (float*)(smem + 68864);
  float* betas = (float*)(smem + 69120);
  int it0 = vb, it1 = 384, itstep = nvb, lp = 0;
  char* base8 = smem;
  if (nvb >= 512) {
    const int bb = vb >> 1, sb = vb & 1;
    itstep = 1;
    if (bb < 128) { it0 = bb; it1 = bb + 1; lp = sb ? 2 : 1; base8 = smem - sb * LDS_BYTES; }
    else if (bb < 256) { it0 = 128 + 2 * (bb - 128) + sb; it1 = it0 + 1; }
    else { it0 = 0; it1 = 0; }
  }
  for (int it = it0; it < it1; it += itstep) {
    const int w = tid0 >> 6;
    int tidA = tid0;
    asm volatile("" : "+v"(tidA));
    const int dv0 = 32 * w + (tidA & 31), h0_ = (tidA & 63) >> 5;
    int s, rem;
    if (it < 128) { s = 16 + (it >> 4); rem = it & 15; } else { s = (it - 128) >> 4; rem = (it - 128) & 15; }
    const int hd = rem >> 1, d = rem & 1;
    const int ss = seq_start(s), len = seq_len(s), nch = len >> 6, gch0 = ss >> 6;
    f32x16 S[4];
    if (s >= 16 && lp != 2) {
      const float* src = P.state_delta + ((size_t)((((s - 16) * 2 + j) * 2 + d) * 8 + hd)) * 16384;
#pragma unroll
      for (int mt = 0; mt < 4; ++mt)
#pragma unroll
        for (int i = 0; i < 16; ++i) S[mt][i] = src[(32 * mt + crow(i, h0_)) * 128 + dv0];
    } else {
#pragma unroll
      for (int mt = 0; mt < 4; ++mt)
#pragma unroll
        for (int i = 0; i < 16; ++i) S[mt][i] = 0.f;
    }
    const int nsteps = lp ? nch + 1 : nch;
    unsigned vpn[2][8];
#pragma unroll
    for (int tt = 0; tt < 2; ++tt)
#pragma unroll
      for (int e = 0; e < 8; ++e) vpn[tt][e] = 0u;
#pragma unroll 1
    for (int t = 0; t < nsteps; ++t) {
      int tid = tid0;
      asm volatile("" : "+v"(tid));
      const int lane = tid & 63, r = lane & 31, h_ = lane >> 5;
      const int dv = 32 * w + r;
      char* sbL = lp ? base8 + (t & 1) * LDS_BYTES : smem;
      char* sbC = lp ? base8 + ((t + 1) & 1) * LDS_BYTES : smem;
      if (lp != 1 && t < nch) {
        const int cd = t;
        const int item = ((gch0 + cd) * 8 + hd) * 2 + d;
        bf16* ksmL = (bf16*)sbL; bf16* qsmL = (bf16*)(sbL + 16896); bf16* kTL = (bf16*)(sbL + 33792);
        bf16* TsmL = (bf16*)(sbL + 51200); bf16* QKsmL = (bf16*)(sbL + 59904);
        float* egcL = (float*)(sbL + 68608); float* edecL = (float*)(sbL + 68864); float* betasL = (float*)(sbL + 69120);
      uint4 kvr[4], qvr[4], tvr[2], qkr[2];
#pragma unroll
      for (int e = 0; e < 4; ++e) {
        const int p = tid + 256 * e, i = p >> 4, cp = p & 15;
        const int row = ss + (d ? len - 1 - (64 * cd + i) : 64 * cd + i);
        kvr[e] = *(const uint4*)(Kb + (size_t)row * 1024 + hd * 128 + cp * 8);
        qvr[e] = *(const uint4*)(Q + (size_t)row * 1024 + hd * 128 + cp * 8);
      }
#pragma unroll
      for (int e = 0; e < 2; ++e) {
        const int p = tid + 256 * e, i = p >> 3, cp = p & 7;
        tvr[e] = *(const uint4*)(TB + (size_t)item * 4096 + i * 64 + cp * 8);
        qkr[e] = *(const uint4*)(QKB + (size_t)item * 4096 + i * 64 + cp * 8);
      }
      __builtin_amdgcn_sched_barrier(0);
#pragma unroll
      for (int e = 0; e < 4; ++e) {
        const int p = tid + 256 * e, i = p >> 4, cp = p & 15;
        const uint4 kv = kvr[e], qv = qvr[e];
        *(uint2*)(ksmL + i * 132 + cp * 8) = make_uint2(kv.x, kv.y);
        *(uint2*)(ksmL + i * 132 + cp * 8 + 4) = make_uint2(kv.z, kv.w);
        *(uint2*)(qsmL + i * 132 + cp * 8) = make_uint2(qv.x, qv.y);
        *(uint2*)(qsmL + i * 132 + cp * 8 + 4) = make_uint2(qv.z, qv.w);
        bf16* kt = kTL + (cp * 8) * 68 + i;
        kt[0 * 68] = (bf16)(kv.x & 0xffffu); kt[1 * 68] = (bf16)(kv.x >> 16);
        kt[2 * 68] = (bf16)(kv.y & 0xffffu); kt[3 * 68] = (bf16)(kv.y >> 16);
        kt[4 * 68] = (bf16)(kv.z & 0xffffu); kt[5 * 68] = (bf16)(kv.z >> 16);
        kt[6 * 68] = (bf16)(kv.w & 0xffffu); kt[7 * 68] = (bf16)(kv.w >> 16);
      }
#pragma unroll
      for (int e = 0; e < 2; ++e) {
        const int p = tid + 256 * e, i = p >> 3, cp = p & 7;
        const uint4 tv = tvr[e], qv = qkr[e];
        *(uint2*)(TsmL + i * 68 + cp * 8) = make_uint2(tv.x, tv.y);
        *(uint2*)(TsmL + i * 68 + cp * 8 + 4) = make_uint2(tv.z, tv.w);
        *(uint2*)(QKsmL + i * 68 + cp * 8) = make_uint2(qv.x, qv.y);
        *(uint2*)(QKsmL + i * 68 + cp * 8 + 4) = make_uint2(qv.z, qv.w);
      }
      {
        const float glastL_ = GC[item * 64 + 63];
        if (tid < 64) {
          const float gc = GC[item * 64 + tid];
          egcL[tid] = __expf(gc); edecL[tid] = __expf(glastL_ - gc); betasL[tid] = BETA[item * 64 + tid];
        }
      }
      }
      const int cd = lp ? t - 1 : t;
      const bool docomp = (lp != 2) && cd >= 0 && cd < nch;
      unsigned vp[2][8];
#pragma unroll
      for (int tt = 0; tt < 2; ++tt)
#pragma unroll
        for (int e = 0; e < 8; ++e) vp[tt][e] = vpn[tt][e];
      unsigned vlo[16], vhi[16];
      const bool vld = (lp != 2) && t < nch;
      if (vld) {
        const int rsv = d ? -1024 : 1024;
        const int rowbv = ss + (d ? len - 1 - 64 * t : 64 * t);
        const bf16* Vbv = V + (size_t)rowbv * 1024 + hd * 128;
#pragma unroll
        for (int tt = 0; tt < 2; ++tt)
#pragma unroll
          for (int e = 0; e < 8; ++e) {
            const int t0 = 32 * tt + crow(2 * e, h_);
            const bf16* p0 = Vbv + t0 * rsv + dv;
            const bf16* p1 = Vbv + (t0 + 1) * rsv + dv;
            asm volatile("global_load_ushort %0, %1, off" : "=v"(vlo[tt * 8 + e]) : "v"(p0) : "memory");
            asm volatile("global_load_ushort %0, %1, off" : "=v"(vhi[tt * 8 + e]) : "v"(p1) : "memory");
          }
      }
#define V_COLLECT()                                                                                                 \
      do {                                                                                                          \
        asm volatile("s_waitcnt vmcnt(0)" : "+v"(vlo[0]), "+v"(vlo[1]), "+v"(vlo[2]), "+v"(vlo[3]), "+v"(vlo[4]), "+v"(vlo[5]), "+v"(vlo[6]), "+v"(vlo[7]), \
                     "+v"(vlo[8]), "+v"(vlo[9]), "+v"(vlo[10]), "+v"(vlo[11]), "+v"(vlo[12]), "+v"(vlo[13]), "+v"(vlo[14]), "+v"(vlo[15]) :: "memory"); \
        asm volatile("" : "+v"(vhi[0]), "+v"(vhi[1]), "+v"(vhi[2]), "+v"(vhi[3]), "+v"(vhi[4]), "+v"(vhi[5]), "+v"(vhi[6]), "+v"(vhi[7]), \
                     "+v"(vhi[8]), "+v"(vhi[9]), "+v"(vhi[10]), "+v"(vhi[11]), "+v"(vhi[12]), "+v"(vhi[13]), "+v"(vhi[14]), "+v"(vhi[15]) :: "memory"); \
        _Pragma("unroll") for (int k_ = 0; k_ < 16; ++k_) vpn[k_ >> 3][k_ & 7] = vlo[k_] | (vhi[k_] << 16);         \
      } while (0)
      if (!lp) {
        __syncthreads();
        if (vld) {
          V_COLLECT();
#pragma unroll
          for (int tt = 0; tt < 2; ++tt)
#pragma unroll
            for (int e = 0; e < 8; ++e) vp[tt][e] = vpn[tt][e];
        }
      }
      if (docomp) {
        const int item = ((gch0 + cd) * 8 + hd) * 2 + d;
        const bf16* ksmC = (const bf16*)sbC; const bf16* qsmC = (const bf16*)(sbC + 16896); const bf16* kTC = (const bf16*)(sbC + 33792);
        const bf16* TsmC = (const bf16*)(sbC + 51200); const bf16* QKsmC = (const bf16*)(sbC + 59904);
        const float* egcC = (const float*)(sbC + 68608); const float* edecC = (const float*)(sbC + 68864); const float* betasC = (const float*)(sbC + 69120);
        const float eglast = __expf(GC[item * 64 + 63]);
        const int rowb = ss + (d ? len - 1 - 64 * cd : 64 * cd);
        bf16* Ob = obuf + (size_t)rowb * DNP + d * 1024 + hd * 128;
        const int ors = d ? -DNP : DNP;
      f32x16 ks[2];
#pragma unroll
      for (int tt = 0; tt < 2; ++tt)
#pragma unroll
        for (int i = 0; i < 16; ++i) ks[tt][i] = 0.f;
      {
        const unsigned a0 = (unsigned)(size_t)sbC + (unsigned)((r * 132 + 4 * h_) * 2), a1 = a0 + 32 * 132 * 2;
        {
          bf16x8 fa[8];
          SC_G8(fa, a0, a1, 0);
          SC_TIE8(fa);
#pragma unroll
          for (int mt = 0; mt < 2; ++mt)
#pragma unroll
            for (int s2 = 0; s2 < 2; ++s2) {
              const bf16x8 bS = pack8(S[mt], s2);
#pragma unroll
              for (int tt = 0; tt < 2; ++tt) ks[tt] = MFMA(fa[(mt * 2 + s2) * 2 + tt], bS, ks[tt]);
            }
        }
        {
          bf16x8 fb[8];
          SC_G8(fb, a0, a1, 16);
          SC_TIE8(fb);
#pragma unroll
          for (int mt = 0; mt < 2; ++mt)
#pragma unroll
            for (int s2 = 0; s2 < 2; ++s2) {
              const bf16x8 bS = pack8(S[2 + mt], s2);
#pragma unroll
              for (int tt = 0; tt < 2; ++tt) ks[tt] = MFMA(fb[(mt * 2 + s2) * 2 + tt], bS, ks[tt]);
            }
        }
      }
      __builtin_amdgcn_sched_barrier(0);
#pragma unroll
      for (int tt = 0; tt < 2; ++tt)
#pragma unroll
        for (int q4 = 0; q4 < 4; ++q4) {
          const float4 eg = *(const float4*)(egcC + 32 * tt + 8 * q4 + 4 * h_);
          const float4 be = *(const float4*)(betasC + 32 * tt + 8 * q4 + 4 * h_);
          ks[tt][4 * q4 + 0] = be.x * (bflo(vp[tt][2 * q4]) - eg.x * ks[tt][4 * q4 + 0]);
          ks[tt][4 * q4 + 1] = be.y * (bfhi(vp[tt][2 * q4]) - eg.y * ks[tt][4 * q4 + 1]);
          ks[tt][4 * q4 + 2] = be.z * (bflo(vp[tt][2 * q4 + 1]) - eg.z * ks[tt][4 * q4 + 2]);
          ks[tt][4 * q4 + 3] = be.w * (bfhi(vp[tt][2 * q4 + 1]) - eg.w * ks[tt][4 * q4 + 3]);
        }
      __builtin_amdgcn_sched_barrier(0);
      f32x16 vn[2];
#pragma unroll
      for (int tt = 0; tt < 2; ++tt)
#pragma unroll
        for (int i = 0; i < 16; ++i) vn[tt][i] = 0.f;
      {
        bf16x8 fa[6];
        const unsigned a0 = (unsigned)(size_t)sbC + 51200u + (unsigned)((r * 68 + 4 * h_) * 2), a1 = a0 + 32 * 68 * 2;
        SC_G6(fa, a0, a1);
        SC_TIE6(fa);
        const bf16x8 bR00 = pack8(ks[0], 0), bR01 = pack8(ks[0], 1), bR10 = pack8(ks[1], 0), bR11 = pack8(ks[1], 1);
        vn[0] = MFMA(fa[0], bR00, vn[0]); vn[1] = MFMA(fa[1], bR00, vn[1]);
        vn[0] = MFMA(fa[2], bR01, vn[0]); vn[1] = MFMA(fa[3], bR01, vn[1]);
        vn[1] = MFMA(fa[4], bR10, vn[1]); vn[1] = MFMA(fa[5], bR11, vn[1]);
      }
      __builtin_amdgcn_sched_barrier(0);
      f32x16 oa[2];
#pragma unroll
      for (int tt = 0; tt < 2; ++tt)
#pragma unroll
        for (int i = 0; i < 16; ++i) oa[tt][i] = 0.f;
      {
        const unsigned a0 = (unsigned)(size_t)sbC + 16896u + (unsigned)((r * 132 + 4 * h_) * 2), a1 = a0 + 32 * 132 * 2;
        {
          bf16x8 fa[8];
          SC_G8(fa, a0, a1, 0);
          SC_TIE8(fa);
#pragma unroll
          for (int mt = 0; mt < 2; ++mt)
#pragma unroll
            for (int s2 = 0; s2 < 2; ++s2) {
              const bf16x8 bS = pack8(S[mt], s2);
#pragma unroll
              for (int tt = 0; tt < 2; ++tt) oa[tt] = MFMA(fa[(mt * 2 + s2) * 2 + tt], bS, oa[tt]);
            }
        }
        {
          bf16x8 fb[8];
          SC_G8(fb, a0, a1, 16);
          SC_TIE8(fb);
#pragma unroll
          for (int mt = 0; mt < 2; ++mt)
#pragma unroll
            for (int s2 = 0; s2 < 2; ++s2) {
              const bf16x8 bS = pack8(S[2 + mt], s2);
#pragma unroll
              for (int tt = 0; tt < 2; ++tt) oa[tt] = MFMA(fb[(mt * 2 + s2) * 2 + tt], bS, oa[tt]);
            }
        }
      }
#pragma unroll
      for (int tt = 0; tt < 2; ++tt)
#pragma unroll
        for (int q4 = 0; q4 < 4; ++q4) {
          const float4 eg = *(const float4*)(egcC + 32 * tt + 8 * q4 + 4 * h_);
          oa[tt][4 * q4 + 0] *= eg.x; oa[tt][4 * q4 + 1] *= eg.y; oa[tt][4 * q4 + 2] *= eg.z; oa[tt][4 * q4 + 3] *= eg.w;
        }
      {
        bf16x8 fa[6];
        const unsigned a0 = (unsigned)(size_t)sbC + 59904u + (unsigned)((r * 68 + 4 * h_) * 2), a1 = a0 + 32 * 68 * 2;
        SC_G6(fa, a0, a1);
        SC_TIE6(fa);
        const bf16x8 bV00 = pack8(vn[0], 0), bV01 = pack8(vn[0], 1), bV10 = pack8(vn[1], 0), bV11 = pack8(vn[1], 1);
        oa[0] = MFMA(fa[0], bV00, oa[0]); oa[1] = MFMA(fa[1], bV00, oa[1]);
        oa[0] = MFMA(fa[2], bV01, oa[0]); oa[1] = MFMA(fa[3], bV01, oa[1]);
        oa[1] = MFMA(fa[4], bV10, oa[1]); oa[1] = MFMA(fa[5], bV11, oa[1]);
      }
#pragma unroll
      for (int tt = 0; tt < 2; ++tt)
#pragma unroll
        for (int i = 0; i < 16; ++i) {
          const int t = 32 * tt + crow(i, h_);
          Ob[t * ors + dv] = f2bf(oa[tt][i]);
        }
      __builtin_amdgcn_sched_barrier(0);
#pragma unroll
      for (int tt = 0; tt < 2; ++tt)
#pragma unroll
        for (int q4 = 0; q4 < 4; ++q4) {
          const float4 ed = *(const float4*)(edecC + 32 * tt + 8 * q4 + 4 * h_);
          vn[tt][4 * q4 + 0] *= ed.x; vn[tt][4 * q4 + 1] *= ed.y; vn[tt][4 * q4 + 2] *= ed.z; vn[tt][4 * q4 + 3] *= ed.w;
        }
#pragma unroll
      for (int mt = 0; mt < 4; ++mt)
#pragma unroll
        for (int i = 0; i < 16; ++i) S[mt][i] *= eglast;
      {
        const unsigned b0 = (unsigned)(size_t)sbC + 33792u + (unsigned)((r * 68 + 4 * h_) * 2);
        const unsigned b1 = b0 + 32 * 68 * 2, b2 = b0 + 64 * 68 * 2, b3 = b0 + 96 * 68 * 2;
        {
          bf16x8 fa[8];
          SC_G8T(fa, b0, b1, b2, b3, 0);
          SC_TIE8(fa);
#pragma unroll
          for (int s2 = 0; s2 < 2; ++s2) {
            const bf16x8 bV = pack8(vn[0], s2);
#pragma unroll
            for (int mt = 0; mt < 4; ++mt) S[mt] = MFMA(fa[s2 * 4 + mt], bV, S[mt]);
          }
        }
        {
          bf16x8 fb[8];
          SC_G8T(fb, b0, b1, b2, b3, 8);
          SC_TIE8(fb);
#pragma unroll
          for (int s2 = 0; s2 < 2; ++s2) {
            const bf16x8 bV = pack8(vn[1], s2);
#pragma unroll
            for (int mt = 0; mt < 4; ++mt) S[mt] = MFMA(fb[s2 * 4 + mt], bV, S[mt]);
          }
        }
      }
      }
      if (lp == 1 && vld) V_COLLECT();
      __syncthreads();
    }
#undef V_COLLECT
    if (s < 16) {
      int tidB = tid0;
      asm volatile("" : "+v"(tidB));
      const int dv0 = 32 * w + (tidB & 31), h0_ = (tidB & 63) >> 5;
      float* dst = P.out + OUT_STATE + ((size_t)(((s * 2 + j) * 2 + d) * 8 + hd)) * 16384;
#pragma unroll
      for (int mt = 0; mt < 4; ++mt)
#pragma unroll
        for (int i = 0; i < 16; ++i) dst[(32 * mt + crow(i, h0_)) * 128 + dv0] = S[mt][i];
    }
  }
}

DI void phase_dngate(const Params& P, int wv, int vb, int nvb, int j) {
  const int lane = get_tid(wv) & 63, wave = get_tid(wv) >> 6;
  const bf16* proj = (const bf16*)(P.ws + OFF_P);
  bf16* H = (bf16*)(P.ws + OFF_H);
  const int nw = nvb * 4;
  const int c0 = 16 * lane;
  float g[16];
#pragma unroll
  for (int e = 0; e < 16; ++e) g[e] = P.dn_onorm_g[j * 128 + (c0 & 127) + e];
  for (int row = vb * 4 + wave; row < NTOK; row += nw) {
    const bf16* pr = proj + (size_t)row * DNP;
    uint4 a0 = *(const uint4*)(pr + c0), a1 = *(const uint4*)(pr + c0 + 8);
    uint4 b0 = *(const uint4*)(pr + 1024 + c0), b1 = *(const uint4*)(pr + 1024 + c0 + 8);
    uint4 z0 = *(const uint4*)(pr + 3072 + c0), z1 = *(const uint4*)(pr + 3072 + c0 + 8);
    unsigned au[8] = {a0.x, a0.y, a0.z, a0.w, a1.x, a1.y, a1.z, a1.w};
    unsigned bu[8] = {b0.x, b0.y, b0.z, b0.w, b1.x, b1.y, b1.z, b1.w};
    unsigned zu[8] = {z0.x, z0.y, z0.z, z0.w, z1.x, z1.y, z1.z, z1.w};
    float o[16], z[16];
    float ss = 0.f;
#pragma unroll
    for (int e = 0; e < 8; ++e) {
      o[2 * e] = bflo(au[e]) + bflo(bu[e]); o[2 * e + 1] = bfhi(au[e]) + bfhi(bu[e]);
      z[2 * e] = bflo(zu[e]); z[2 * e + 1] = bfhi(zu[e]);
      ss += o[2 * e] * o[2 * e] + o[2 * e + 1] * o[2 * e + 1];
    }
    ss += shx(ss, 1, lane); ss += shx(ss, 2, lane); ss += shx(ss, 4, lane);
    const float rstd = rsqrtf(ss * (1.f / 128.f) + EPS);
    unsigned pk[8];
#pragma unroll
    for (int e = 0; e < 8; ++e) {
      float v0 = o[2 * e] * rstd * g[2 * e] * siluf(z[2 * e]);
      float v1 = o[2 * e + 1] * rstd * g[2 * e + 1] * siluf(z[2 * e + 1]);
      pk[e] = pack2(v0, v1);
    }
    uint4* hp = (uint4*)(H + (size_t)row * 1024 + c0);
    hp[0] = make_uint4(pk[0], pk[1], pk[2], pk[3]);
    hp[1] = make_uint4(pk[4], pk[5], pk[6], pk[7]);
  }
}

DI void phase_atpost(const Params& P, int wv, int vb, int nvb, int j) {
  const int lane = get_tid(wv) & 63, wave = get_tid(wv) >> 6;
  const float* QKV = (const float*)(P.ws + OFF_P);
  bf16* Qb = (bf16*)(P.ws + OFF_AQ);
  bf16* Kb = (bf16*)(P.ws + OFF_AK);
  bf16* VT = (bf16*)(P.ws + OFF_AVT);
  const int nw = nvb * 4;
  const int f = lane & 15, hb = (lane >> 4) & 1;
  const float inv = exp2f(-(float)f * (13.287712379549449f / 16.f));
  for (int row = vb * 4 + wave; row < NTOK; row += nw) {
    const int s = seq_of_row(row), ss = seq_start(s), len = seq_len(s);
    const int t = row - ss;
    const bool smp = row >= NPR;
    const float* src = QKV + (size_t)row * ATP;
    float cs = 1.f, sn = 0.f;
    if (smp) { const float p = (float)(hb ? (t & 63) : (t >> 6)); sincosf(p * inv, &sn, &cs); }
#pragma unroll
    for (int i = 0; i < 8; ++i) {
      const int pi = i * 64 + lane;
      const int c1 = (pi >> 5) * 64 + hb * 32 + f;
      const float x1 = src[c1], x2 = src[c1 + 16];
      const float o1 = x1 * cs - x2 * sn, o2 = x1 * sn + x2 * cs;
      Qb[(size_t)row * 1024 + c1] = f2bf(o1 * 0.125f);
      Qb[(size_t)row * 1024 + c1 + 16] = f2bf(o2 * 0.125f);
    }
#pragma unroll
    for (int i = 0; i < 2; ++i) {
      const int pi = i * 64 + lane;
      const int c1 = (pi >> 5) * 64 + hb * 32 + f;
      const float x1 = src[1024 + c1], x2 = src[1024 + c1 + 16];
      const float o1 = x1 * cs - x2 * sn, o2 = x1 * sn + x2 * cs;
      Kb[(size_t)row * 256 + c1] = f2bf(o1);
      Kb[(size_t)row * 256 + c1 + 16] = f2bf(o2);
      if (!smp) {
        float* ck = P.out + OUT_CK + ((size_t)((s * 2 + j) * 256 + t)) * 256;
        ck[c1] = x1; ck[c1 + 16] = x2;
      }
    }
#pragma unroll
    for (int i = 0; i < 4; ++i) {
      const int cc = i * 64 + lane;
      const float x = src[1280 + cc];
      VT[(size_t)ss * 256 + (size_t)cc * len + t] = f2bf(x);
      if (!smp) P.out[OUT_CV + ((size_t)((s * 2 + j) * 256 + t)) * 256 + cc] = x;
    }
  }
}

DI void phase_attn(const Params& P, int wv, int vb, int nvb, int j, char* smem) {
  const int tid = get_tid(wv), lane = tid & 63, w = (tid >> 6) & 3, r = lane & 31, h_ = lane >> 5;
  const bf16* Qb = (const bf16*)(P.ws + OFF_AQ);
  const bf16* Kb = (const bf16*)(P.ws + OFF_AK);
  const bf16* VT = (const bf16*)(P.ws + OFF_AVT);
  const bf16* Kc = (const bf16*)(P.ws + OFF_KC);
  const bf16* Vct = (const bf16*)(P.ws + OFF_VCT);
  bf16* AO = (bf16*)(P.ws + OFF_H);
  bf16* Ksm = (bf16*)smem;
  bf16* Vsm = (bf16*)(smem + 4608);
  const int lk = tid >> 3, lkc = (tid & 7) * 8;
  const int ld = tid >> 2, ldc = (tid & 3) * 8;
  for (int it = vb; it < 1536; it += nvb) {
    int b, head, qblk; bool smp;
    if (it < 1024) { smp = true; b = it >> 7; head = (it >> 3) & 15; qblk = it & 7; }
    else { const int u = it - 1024; smp = false; b = u >> 5; head = (u >> 1) & 15; qblk = u & 1; }
    const int s = smp ? 16 + b : b, ss = seq_start(s), len = seq_len(s);
    const int kvh = head >> 2;
    const int qb0 = qblk * 128;
    const int q0 = qb0 + w * 32;
    const int qrow = ss + q0 + r;
    bf16x8 bq[4];
#pragma unroll
    for (int ks = 0; ks < 4; ++ks) bq[ks] = *(const bf16x8*)(Qb + (size_t)qrow * 1024 + head * 64 + ks * 16 + h_ * 8);
    float m = P.at_sink[j * 16 + head];
    float l = h_ == 0 ? 1.f : 0.f;
    f32x16 oacc[2];
#pragma unroll
    for (int dt = 0; dt < 2; ++dt)
#pragma unroll
      for (int i = 0; i < 16; ++i) oacc[dt][i] = 0.f;
    const bf16* Kp = Kb + (size_t)ss * 256 + kvh * 64;
    const bf16* VTp = VT + (size_t)ss * 256 + (size_t)kvh * 64 * len;
    const bf16* Kcp = Kc + (size_t)((b * 2 + j) * 4 + kvh) * 512 * 64;
    const bf16* Vcp = Vct + (size_t)((b * 2 + j) * 4 + kvh) * 64 * 512;
    const int klo = smp ? qb0 - 128 : 0;
    const int nloc = smp ? 12 : 8;
    const int ntile = nloc + (smp ? 16 : 0);
    uint4 kreg = make_uint4(0u, 0u, 0u, 0u), vreg = make_uint4(0u, 0u, 0u, 0u);
    if (klo >= 0) {
      kreg = *(const uint4*)(Kp + (size_t)(klo + lk) * 256 + lkc);
      vreg = *(const uint4*)(VTp + (size_t)ld * len + klo + ldc);
    }
    *(uint4*)(Ksm + lk * 72 + lkc) = kreg;
    *(uint2*)(Vsm + ld * 36 + ldc) = make_uint2(vreg.x, vreg.y);
    *(uint2*)(Vsm + ld * 36 + ldc + 4) = make_uint2(vreg.z, vreg.w);
    __syncthreads();
#pragma unroll 1
    for (int t = 0; t < ntile; ++t) {
      const bf16* Kcur = Ksm + (t & 1) * 4608;
      const bf16* Vcur = Vsm + (t & 1) * 4608;
      bool have_next = false;
      if (t + 1 < ntile) {
        const int tn = t + 1;
        if (tn < nloc) {
          const int key0n = klo + tn * 32;
          if (key0n >= 0 && key0n < len) {
            kreg = *(const uint4*)(Kp + (size_t)(key0n + lk) * 256 + lkc);
            vreg = *(const uint4*)(VTp + (size_t)ld * len + key0n + ldc);
            have_next = true;
          }
        } else {
          const int key0n = (tn - nloc) * 32;
          kreg = *(const uint4*)(Kcp + (size_t)(key0n + lk) * 64 + lkc);
          vreg = *(const uint4*)(Vcp + (size_t)ld * 512 + key0n + ldc);
          have_next = true;
        }
      }
      const bool local = t < nloc;
      const int key0 = klo + t * 32;
      const bool skip_empty = local && (key0 < 0 || key0 >= len);
      const bool skip_win = local && smp && (key0 + 31 < q0 - 128 || key0 > q0 + 31 + 128);
      if (!skip_empty && !skip_win) {
      f32x16 sa;
#pragma unroll
      for (int i = 0; i < 16; ++i) sa[i] = 0.f;
#pragma unroll
      for (int ks = 0; ks < 4; ++ks) {
        bf16x8 a = *(const bf16x8*)(Kcur + r * 72 + ks * 16 + h_ * 8);
        sa = MFMA(a, bq[ks], sa);
      }
      if (local && smp && !(key0 >= q0 + 31 - 128 && key0 + 31 <= q0 + 128)) {
        const int qpos = q0 + r;
#pragma unroll
        for (int i = 0; i < 16; ++i) {
          const int dd = qpos - (key0 + crow(i, h_));
          if (dd > 128 || dd < -128) sa[i] = -INFINITY;
        }
      }
      float tmax = sa[0];
#pragma unroll
      for (int i = 1; i < 16; ++i) tmax = fmaxf(tmax, sa[i]);
      tmax = fmaxf(tmax, shx(tmax, 32, lane));
      const float mnew = fmaxf(m, tmax);
      if (__ballot(mnew > m) != 0ull) {
        const float alpha = __expf(m - mnew);
        l *= alpha;
#pragma unroll
        for (int dt = 0; dt < 2; ++dt)
#pragma unroll
          for (int i = 0; i < 16; ++i) oacc[dt][i] *= alpha;
      }
      m = mnew;
      float ls = 0.f;
#pragma unroll
      for (int i = 0; i < 16; ++i) { sa[i] = __expf(sa[i] - mnew); ls += sa[i]; }
      l += ls;
#pragma unroll
      for (int s2 = 0; s2 < 2; ++s2) {
        const bf16x8 bp = pack8(sa, s2);
#pragma unroll
        for (int dt = 0; dt < 2; ++dt) {
          const bf16* ap = Vcur + (32 * dt + r) * 36 + 16 * s2 + 4 * h_;
          oacc[dt] = MFMA(frag2(*(const uint2*)ap, *(const uint2*)(ap + 8)), bp, oacc[dt]);
        }
      }
      }
      if (have_next) {
        bf16* Kn = Ksm + ((t + 1) & 1) * 4608;
        bf16* Vn = Vsm + ((t + 1) & 1) * 4608;
        *(uint4*)(Kn + lk * 72 + lkc) = kreg;
        *(uint2*)(Vn + ld * 36 + ldc) = make_uint2(vreg.x, vreg.y);
        *(uint2*)(Vn + ld * 36 + ldc + 4) = make_uint2(vreg.z, vreg.w);
      }
      __syncthreads();
    }
    l += shx(l, 32, lane);
    const float il = 1.f / l;
#pragma unroll
    for (int dt = 0; dt < 2; ++dt)
#pragma unroll
      for (int q4 = 0; q4 < 4; ++q4) {
        const int dd = 32 * dt + 8 * q4 + 4 * h_;
        *(uint2*)(AO + (size_t)qrow * 1024 + head * 64 + dd) =
            make_uint2(pack2(oacc[dt][4 * q4] * il, oacc[dt][4 * q4 + 1] * il), pack2(oacc[dt][4 * q4 + 2] * il, oacc[dt][4 * q4 + 3] * il));
      }
  }
}

DI void phase_ffnconv(const Params& P, int wv, int vb, int nvb, int layer) {
  const int tid = get_tid(wv);
  const bf16* halo = (const bf16*)(P.ws + OFF_HALO);
  bf16* ACT = (bf16*)(P.ws + OFF_A);
  const float* cw = P.ffn_conv_w + (size_t)layer * 3 * FF2;
  const float* cbv = P.ffn_conv_b + (size_t)layer * FF2;
  const int fl = tid & 127, which = tid >> 7;
  for (int item = vb; item < 24 * 22; item += nvb) {
    const int b = item / 22, nb = item % 22;
    const int sq = b / 3, k = b % 3 + 1;
    const int mtA = 16 + sq * 4 + (k - 1);
    const int R = NPR + sq * 1024 + 256 * k - 1;
    const bf16* HA = halo + (size_t)(mtA * 22 + nb) * 4 * 256;
    const bf16* HB = halo + (size_t)((mtA + 1) * 22 + nb) * 4 * 256;
    const bf16* pp = which ? HA + 3 * 256 : HA + 2 * 256;
    const bf16* pc = which ? HB : HA + 3 * 256;
    const bf16* pn = which ? HB + 256 : HB;
    const int f = nb * 128 + fl;
    const float ua = cw[f] * bf2f(pp[fl]) + cw[FF2 + f] * bf2f(pc[fl]) + cw[2 * FF2 + f] * bf2f(pn[fl]) + cbv[f];
    const float ub = cw[FF + f] * bf2f(pp[128 + fl]) + cw[FF2 + FF + f] * bf2f(pc[128 + fl]) + cw[2 * FF2 + FF + f] * bf2f(pn[128 + fl]) + cbv[FF + f];
    ACT[(size_t)(R + which) * FF + f] = f2bf(ua / (1.f + __expf(-ua)) * ub);
  }
}

DI void run_phase(const Params& P, int wv8, int ph, char* smem8) {
  const int sub = wv8 >> 2, wv = wv8 & 3;
  int vb = (int)blockIdx.x * 2 + sub;
  asm volatile("" : "+s"(vb));
  const int nvb = (int)gridDim.x * 2;
  char* smem = smem8 + sub * LDS_BYTES;
  const float* mod = (const float*)(P.ws + OFF_MOD);
  if (ph == 0) { phase_pre(P, wv, vb, nvb, smem); return; }
  int layer, st;
  if (ph == 1) { layer = -1; st = 0; }
  else if (ph < 13) { layer = 0; st = ph - 2; }
  else if (ph < 21) { layer = 1; st = ph - 13; }
  else if (ph < 32) { layer = 2; st = ph - 21; }
  else { layer = 3; st = ph - 32; }
  const int j = layer >> 1;
  const bool isdn = (layer & 1) == 0;
  int kind;
  int fst;
  if (layer < 0) { kind = 1; fst = -1; }
  else if (isdn) {
    if (st == 0) { kind = 0; fst = -2; } else if (st == 1) { kind = 2; fst = -1; } else if (st == 2) { kind = 3; fst = -1; }
    else if (st == 3) { kind = 4; fst = -1; } else if (st == 4) { kind = 5; fst = -1; } else { fst = st - 5; kind = -1; }
  } else {
    if (st == 0) { kind = 0; fst = -2; } else if (st == 1) { kind = 7; fst = -1; }
    else { fst = st - 2; kind = -1; }
  }
  if (kind < 0) { kind = (fst == 0 || fst == 2 || fst == 4) ? 0 : (fst == 3 ? 8 : 1); }

  if (kind == 0) {
    const bf16* A; int lda; const bf16* Bt; int K, Npad, N; void* C; int ldc, epi;
    const bf16* H = (const bf16*)(P.ws + OFF_H);
    if (fst == -2) {
      A = H; lda = 1024; K = 1024;
      if (isdn) { Bt = (const bf16*)(P.ws + OFF_WIN + j * SZ_WIN); Npad = DNPAD; N = DNP; C = P.ws + OFF_P; ldc = DNP; epi = 0; }
      else { Bt = (const bf16*)(P.ws + OFF_WQKV + j * SZ_WQKV); Npad = ATP; N = ATP; C = P.ws + OFF_P; ldc = ATP; epi = 4; }
    } else if (fst == 0) {
      A = H; lda = 1024; K = 1024; Npad = 1024; N = 1024; C = P.ws + OFF_P; ldc = 1024; epi = 0;
      Bt = isdn ? (const bf16*)(P.ws + OFF_WOUT + j * SZ_WSQ) : (const bf16*)(P.ws + OFF_WO + j * SZ_WSQ);
    } else if (fst == 2) {
      A = H; lda = 1024; K = 1024; Npad = FF2; N = FF2; C = P.ws + OFF_A; ldc = FF; epi = 3;
      Bt = (const bf16*)(P.ws + OFF_WUP + layer * SZ_WUP);
    } else {
      A = (const bf16*)(P.ws + OFF_A); lda = FF; K = FF; Npad = 1024; N = 1024; C = P.ws + OFF_P; ldc = 1024; epi = 0;
      Bt = (const bf16*)(P.ws + OFF_WDN + layer * SZ_WDN);
    }
    phase_gemm(wv8, A, lda, Bt, K, Npad, N, C, ldc, epi, P.ffn_conv_w + (size_t)(layer < 0 ? 0 : layer) * 3 * FF2, P.ffn_conv_b + (size_t)(layer < 0 ? 0 : layer) * FF2, (bf16*)(P.ws + OFF_HALO), P, j < 0 ? 0 : j, smem8);
  } else if (kind == 1) {
    int mode, gate_idx, do_h, shift_idx, scale_idx;
    const float *ga, *modg, *gb, *modn;
    if (layer < 0) {
      mode = 0; ga = P.norm_g; modg = mod; gate_idx = 0; do_h = 1; gb = P.norm_g; modn = mod; shift_idx = 0; scale_idx = 1;
    } else if (fst == 1) {
      mode = 1; ga = P.norm_g + (layer * 4 + 1) * 1024; modg = mod + layer * 9 * 6144; gate_idx = 2;
      do_h = 1; gb = P.norm_g + (layer * 4 + 2) * 1024; modn = modg; shift_idx = 3; scale_idx = 4;
    } else {
      mode = 1; ga = P.norm_g + (layer * 4 + 3) * 1024; modg = mod + layer * 9 * 6144; gate_idx = 5;
      do_h = layer < 3 ? 1 : 0;
      const int nl = layer < 3 ? layer + 1 : 3;
      gb = P.norm_g + (nl * 4 + 0) * 1024; modn = mod + nl * 9 * 6144; shift_idx = 0; scale_idx = 1;
    }
    phase_rowepi(P, wv, vb, nvb, mode, ga, modg, gate_idx, do_h, gb, modn, shift_idx, scale_idx);
  } else if (kind == 2) phase_dnconv(P, wv, vb, nvb, j);
  else if (kind == 3) phase_dnprep(P, wv, vb, nvb, j, smem);
  else if (kind == 4) phase_dnscan(P, wv, vb, nvb, j, smem);
  else if (kind == 5) phase_dngate(P, wv, vb, nvb, j);
  else if (kind == 6) { }
  else if (kind == 7) phase_attn(P, wv, vb, nvb, j, smem);
  else phase_ffnconv(P, wv, vb, nvb, layer);
}


#define XB_TMO      128
#define XB_XCNT(j)  (256  + 64 * (j))
#define XB_XSUB(j)  (1280 + 64 * (j))
#define XB_XGEN(j)  (2304 + 64 * (j))
#define XB_TOP      3328
#define XB_TOPGEN   3392
#define XCD_BAR_WORDS 3456
#define XB_SPIN_CAP (1u << 18)
#define LAS __attribute__((address_space(3)))
DI unsigned xb_ld(unsigned* p) { return __hip_atomic_load(p, __ATOMIC_RELAXED, __HIP_MEMORY_SCOPE_AGENT); }
DI unsigned xb_add(unsigned* p, unsigned v) { return __hip_atomic_fetch_add(p, v, __ATOMIC_RELAXED, __HIP_MEMORY_SCOPE_AGENT); }
DI unsigned xb_xcc_id() { return (unsigned)__builtin_amdgcn_s_getreg((3 << 11) | 20) & 0xFu; }
#define XB_SPIN(cond, bar) do { unsigned _sp = 0; while (cond) { __builtin_amdgcn_s_sleep(1); \
    if ((++_sp & 255u) == 0u) { if (xb_ld(&(bar)[XB_TMO])) break; if (_sp > XB_SPIN_CAP) { atomicAdd(&(bar)[XB_TMO], 1u); break; } } } } while (0)
struct XcdBarrier { unsigned* bar; unsigned x; volatile LAS unsigned* st; };
DI XcdBarrier xcd_barrier_post(unsigned* bar, volatile LAS unsigned* st) {
  XcdBarrier b; b.bar = bar; b.x = xb_xcc_id(); b.st = st;
  if (threadIdx.x == 0) (void)xb_add(&bar[XB_XCNT(b.x)], 1u);
  return b;
}
DI void xcd_barrier_complete(unsigned* bar, unsigned x, unsigned& nloc, unsigned& nx) {
  const unsigned G = gridDim.x * gridDim.y * gridDim.z;
  unsigned sum, cnt, mine, sp = 0u;
  for (;;) {
    sum = 0u; cnt = 0u; mine = 0u;
#pragma unroll
    for (unsigned j = 0; j < 16; ++j) { const unsigned c = xb_ld(&bar[XB_XCNT(j)]); sum += c; cnt += (c > 0u) ? 1u : 0u; mine = (j == x) ? c : mine; }
    if (sum == G) break;
    __builtin_amdgcn_s_sleep(1);
    if ((++sp & 255u) == 0u) { if (xb_ld(&bar[XB_TMO])) break; if (sp > XB_SPIN_CAP) { atomicAdd(&bar[XB_TMO], 1u); break; } }
  }
  nloc = mine > 0u ? mine : 1u; nx = cnt > 0u ? cnt : 1u;
}
DI void xcd_barrier(const XcdBarrier& b, int wv) {
  asm volatile("s_waitcnt vmcnt(0)" ::: "memory");
  __syncthreads();
  if (wv == 0 && lane_id_opaque() == 0) {
    unsigned* bar = b.bar;
    __builtin_amdgcn_s_waitcnt(0);
    unsigned nloc = b.st[0], nx = b.st[1];
    if (nloc == 0u) { xcd_barrier_complete(bar, b.x, nloc, nx); b.st[0] = nloc; b.st[1] = nx; }
    const unsigned old = xb_add(&bar[XB_XSUB(b.x)], 1u);
    const unsigned gen = old / nloc;
    if (old + 1u == (gen + 1u) * nloc) {
      __builtin_amdgcn_fence(__ATOMIC_RELEASE, "agent");
      asm volatile("s_waitcnt vmcnt(0)" ::: "memory");
      const unsigned og = xb_add(&bar[XB_TOP], 1u);
      const unsigned tg = og / nx;
      if (og + 1u == (tg + 1u) * nx) xb_add(&bar[XB_TOPGEN], 1u);
      else XB_SPIN(xb_ld(&bar[XB_TOPGEN]) == tg, bar);
      __builtin_amdgcn_fence(__ATOMIC_ACQUIRE, "agent");
      xb_add(&bar[XB_XGEN(b.x)], 1u);
      asm volatile("s_waitcnt vmcnt(0)" ::: "memory");
    } else {
      XB_SPIN(xb_ld(&bar[XB_XGEN(b.x)]) == gen, bar);
      __builtin_amdgcn_fence(__ATOMIC_ACQUIRE, "agent");
      asm volatile("s_waitcnt vmcnt(0)" ::: "memory");
    }
  }
  __syncthreads();
}
constexpr size_t OFF_BAR = 917504;

#ifndef DUPMASK
#define DUPMASK 0
#endif
DI int phase_kind(int ph) {
  if (ph == 0) return 9;
  if (ph == 1) return 1;
  int st; bool isdn;
  if (ph < 13) { isdn = true; st = ph - 2; } else if (ph < 21) { isdn = false; st = ph - 13; }
  else if (ph < 32) { isdn = true; st = ph - 21; } else { isdn = false; st = ph - 32; }
  int fst;
  if (isdn) { if (st == 0) return 0; if (st <= 4) return st + 1; fst = st - 5; }
  else { if (st == 0) return 0; if (st == 1) return 7; fst = st - 2; }
  return (fst == 0 || fst == 2 || fst == 4) ? 0 : (fst == 3 ? 8 : 1);
}
__global__ void __launch_bounds__(512, 2) mega_kernel(Params P, int p0, int p1) {
  __shared__ __attribute__((aligned(1024))) char smem[2 * LDS_BYTES];
  __shared__ uint4 xb_words;
  const int wv = __builtin_amdgcn_readfirstlane((int)(threadIdx.x >> 6));
  cg::grid_group grid = cg::this_grid();
  if (threadIdx.x == 0) xb_words = make_uint4(0u, 0u, 0u, 0u);
  __syncthreads();
  if (p1 < 0) grid.sync();
  XcdBarrier xb = xcd_barrier_post((unsigned*)(P.ws + OFF_BAR), (volatile LAS unsigned*)&xb_words);
#if DUPMASK
  int ph = p0, q = 0;
  while (ph < p1) {
    run_phase(P, wv, ph, smem);
    const int reps = 1 + ((DUPMASK >> phase_kind(ph)) & 1);
    ++q;
    if (q >= reps) { q = 0; ++ph; }
    if (ph < p1) xcd_barrier(xb, wv);
    if ((DUPMASK >> 10) & 1) xcd_barrier(xb, wv);
  }
#else
  for (int ph = p0; ph < p1; ++ph) {
    run_phase(P, wv, ph, smem);
    if (ph + 1 < p1) xcd_barrier(xb, wv);
    if (ph + 1 < p1) { const int nk = phase_kind(ph + 1); if (nk == 7 || nk == 8 || phase_kind(ph) == 7) xcd_barrier(xb, wv); }
  }
#endif
}

extern "C" void kernel_launch(void* const* d_in, const int* in_sizes, int n_in, void* d_out, int out_size,
                              void* d_ws, size_t ws_size, hipStream_t stream) {
  static int grid_blocks = 0;
  if (!grid_blocks) {
    int dev = 0, cus = 0, per_cu = 0;
    hipGetDevice(&dev);
    hipDeviceGetAttribute(&cus, hipDeviceAttributeMultiprocessorCount, dev);
    hipOccupancyMaxActiveBlocksPerMultiprocessor(&per_cu, mega_kernel, 512, 0);
    if (per_cu > 1) per_cu = 1;
    if (per_cu < 1) per_cu = 1;
    grid_blocks = cus * per_cu;
  }
  if (ws_size < WS_NEEDED) { fprintf(stderr, "workspace too small: %zu < %zu\n", ws_size, (size_t)WS_NEEDED); return; }
  Params p;
  memset(&p, 0, sizeof(p));
  const float** fp = (const float**)&p;
  for (int i = 0; i < 23; ++i) fp[i] = (const float*)d_in[i];
  p.out = (float*)d_out;
  p.ws = (char*)d_ws;
  hipMemsetAsync((char*)d_ws + OFF_BAR, 0, XCD_BAR_WORDS * sizeof(unsigned), stream);
#if MULTI_LAUNCH
  for (int ph = 0; ph < NPH; ++ph) hipLaunchKernelGGL(mega_kernel, dim3(grid_blocks), dim3(512), 0, stream, p, ph, ph + 1);
#else
  int p0 = 0, p1 = NPH;
  void* args[] = {&p, &p0, &p1};
  hipError_t e = hipLaunchCooperativeKernel((void*)mega_kernel, dim3(grid_blocks), dim3(512), args, 0, stream);
  if (e != hipSuccess) fprintf(stderr, "cooperative launch failed: %s (grid %d)\n", hipGetErrorString(e), grid_blocks);
#endif
}
```

```cpp
#include <hip/hip_runtime.h>
#include <hip/hip_cooperative_groups.h>
#include <cstdio>
#include <cstring>
namespace cg = cooperative_groups;

#ifndef MULTI_LAUNCH
#define MULTI_LAUNCH 0
#endif

#define DI __device__ __forceinline__
typedef unsigned short bf16;
using bf16x8 = __attribute__((ext_vector_type(8))) short;
using f32x16 = __attribute__((ext_vector_type(16))) float;
using u32x4 = __attribute__((ext_vector_type(4))) unsigned;
using f32x4n = __attribute__((ext_vector_type(4))) float;
DI void nt_store4(float* p, float a, float b, float c, float d) { f32x4n v = {a, b, c, d}; __builtin_nontemporal_store(v, (f32x4n*)p); }
DI float4 nt_load4(const float* p) { const f32x4n v = __builtin_nontemporal_load((const f32x4n*)p); return make_float4(v[0], v[1], v[2], v[3]); }
typedef __bf16 bf16v2 __attribute__((ext_vector_type(2)));
typedef float f32v2 __attribute__((ext_vector_type(2)));
#define MFMA(a, b, c) __builtin_amdgcn_mfma_f32_32x32x16_bf16((a), (b), (c), 0, 0, 0)

DI unsigned pack2(float a, float b) { f32v2 v = {a, b}; bf16v2 r = __builtin_convertvector(v, bf16v2); return __builtin_bit_cast(unsigned, r); }
DI bf16 f2bf(float a) { return (bf16)(pack2(a, 0.f) & 0xffffu); }
DI float bf2f(bf16 b) { return __uint_as_float(((unsigned)b) << 16); }
DI float bflo(unsigned u) { return __uint_as_float(u << 16); }
DI float bfhi(unsigned u) { return __uint_as_float(u & 0xffff0000u); }
DI int crow(int reg, int h) { return (reg & 3) + 8 * (reg >> 2) + 4 * h; }
DI bf16x8 pack8(const f32x16& x, int s) {
  u32x4 p;
  p[0] = pack2(x[8 * s + 0], x[8 * s + 1]); p[1] = pack2(x[8 * s + 2], x[8 * s + 3]);
  p[2] = pack2(x[8 * s + 4], x[8 * s + 5]); p[3] = pack2(x[8 * s + 6], x[8 * s + 7]);
  return __builtin_bit_cast(bf16x8, p);
}
DI bf16x8 frag2(uint2 lo, uint2 hi) { u32x4 p = {lo.x, lo.y, hi.x, hi.y}; return __builtin_bit_cast(bf16x8, p); }
DI int lane_id_opaque() { unsigned z = 0u; asm volatile("" : "+v"(z)); return (int)__builtin_amdgcn_mbcnt_hi(~0u, __builtin_amdgcn_mbcnt_lo(~0u, z)); }
DI int get_tid(int wv) { return (wv << 6) | lane_id_opaque(); }
DI float shx(float v, int mask, int lane) { return __int_as_float(__builtin_amdgcn_ds_bpermute((lane ^ mask) << 2, __float_as_int(v))); }
DI float siluf(float x) { return x / (1.f + __expf(-x)); }

constexpr int DM = 1024, NTOK = 12288, NPR = 4096;
constexpr int DNP = 4128, DNPAD = 4352, FF = 2816, FF2 = 5632, ATP = 1536;
constexpr float EPS = 1e-6f;
DI int seq_of_row(int r) { return r < NPR ? (r >> 8) : 16 + ((r - NPR) >> 10); }
DI int seq_start(int s) { return s < 16 ? s * 256 : NPR + (s - 16) * 1024; }
DI int seq_len(int s) { return s < 16 ? 256 : 1024; }
DI int cond_of_row(int r) { return r < NPR ? 0 : 1 + ((r - NPR) >> 10); }

constexpr size_t OFF_MOD = 0;
constexpr size_t OFF_KC = 1u << 20;
constexpr size_t OFF_VCT = OFF_KC + 4194304;
constexpr size_t OFF_WIN = OFF_VCT + 4194304;
constexpr size_t SZ_WIN = (size_t)DNPAD * 1024 * 2;
constexpr size_t OFF_WOUT = OFF_WIN + 2 * SZ_WIN;
constexpr size_t SZ_WSQ = (size_t)1024 * 1024 * 2;
constexpr size_t OFF_WQKV = OFF_WOUT + 2 * SZ_WSQ;
constexpr size_t SZ_WQKV = (size_t)ATP * 1024 * 2;
constexpr size_t OFF_WO = OFF_WQKV + 2 * SZ_WQKV;
constexpr size_t OFF_WUP = OFF_WO + 2 * SZ_WSQ;
constexpr size_t SZ_WUP = (size_t)FF2 * 1024 * 2;
constexpr size_t OFF_WDN = OFF_WUP + 4 * SZ_WUP;
constexpr size_t SZ_WDN = (size_t)1024 * FF * 2;
constexpr size_t OFF_H = OFF_WDN + 4 * SZ_WDN;
constexpr size_t SZ_TB = (size_t)NTOK * 1024 * 2;
constexpr size_t OFF_P = OFF_H + SZ_TB;
constexpr size_t SZ_P = (size_t)NTOK * FF2 * 2;
constexpr size_t OFF_TB = OFF_P + (size_t)NTOK * DNP * 2;
constexpr size_t OFF_HALO = OFF_P + (64u << 20);
constexpr size_t OFF_A = OFF_P + SZ_P;
constexpr size_t OFF_DQ = OFF_A, OFF_DK = OFF_A + SZ_TB, OFF_DV = OFF_A + 2 * SZ_TB, OFF_QK = OFF_A + 3 * SZ_TB;
constexpr size_t OFF_GC = OFF_A + 4 * SZ_TB, OFF_BETA = OFF_GC + 3072 * 64 * 4;
constexpr size_t OFF_AQ = OFF_A, OFF_AK = OFF_A + SZ_TB, OFF_AVT = OFF_AK + (size_t)NTOK * 256 * 2;
constexpr size_t OFF_XB = OFF_BETA + 3072 * 64 * 4;
constexpr size_t WS_NEEDED = OFF_XB + SZ_TB;
static_assert(OFF_TB + SZ_TB <= OFF_A, "T buffer must fit in P tail");
static_assert(WS_NEEDED <= 402653184ull, "workspace too large");
static_assert((size_t)NTOK * FF * 2 <= WS_NEEDED - OFF_A, "act fits");
constexpr int OUT_STATE = 12582912, OUT_CK = 20971520, OUT_CV = 23068672;

constexpr int LDS_BYTES = 73728;
constexpr int NPH = 40;

struct Params {
  const float *x_prompt, *x_sample, *state_delta, *cache_k, *cache_v, *c, *c_ctx, *w_ada, *b_ada, *norm_g,
      *dn_w_in, *dn_conv_w, *dn_a_log, *dn_dt_bias, *dn_onorm_g, *dn_w_out, *at_w_qkv, *at_sink, *at_w_o,
      *ffn_w_up, *ffn_conv_w, *ffn_conv_b, *ffn_w_down;
  float* out;
  char* ws;
};

DI void phase_pre(const Params& P, int wv, int vb, int nvb, char* smem) {
  const int tid = get_tid(wv), lane = tid & 63, wave = tid >> 6;
  if (vb < 384) {
    float* sc = (float*)smem;
    float* red = (float*)(smem + 36864);
    for (int e = tid; e < 9 * 1024; e += 256) {
      int r = e >> 10, k = e & 1023;
      float v = r == 0 ? P.c_ctx[k] : P.c[(r - 1) * 1024 + k];
      sc[e] = v / (1.f + __expf(-v));
    }
    __syncthreads();
    float* mod = (float*)(P.ws + OFF_MOD);
    for (int tile = vb; tile < 384; tile += nvb) {
      const int l = tile / 96, n0 = (tile % 96) * 64;
      const int c4 = tid & 15, kr = tid >> 4;
      float acc[9][4];
#pragma unroll
      for (int r = 0; r < 9; ++r) { acc[r][0] = acc[r][1] = acc[r][2] = acc[r][3] = 0.f; }
      const float* wp = P.w_ada + (size_t)l * 1024 * 6144 + n0 + c4 * 4;
      for (int k = kr; k < 1024; k += 64) {
        float4 wq[4];
#pragma unroll
        for (int u = 0; u < 4; ++u) wq[u] = nt_load4(wp + (size_t)(k + 16 * u) * 6144);
#pragma unroll
        for (int u = 0; u < 4; ++u)
#pragma unroll
          for (int r = 0; r < 9; ++r) {
            const float s = sc[r * 1024 + k + 16 * u];
            acc[r][0] += s * wq[u].x; acc[r][1] += s * wq[u].y; acc[r][2] += s * wq[u].z; acc[r][3] += s * wq[u].w;
          }
      }
#pragma unroll
      for (int r = 0; r < 9; ++r)
#pragma unroll
        for (int e = 0; e < 4; ++e) {
          float v = acc[r][e];
          v += shx(v, 16, lane); v += shx(v, 32, lane);
          if (lane < 16) red[(wave * 9 + r) * 64 + c4 * 4 + e] = v;
        }
      __syncthreads();
      for (int e = tid; e < 9 * 64; e += 256) {
        int r = e >> 6, cc = e & 63;
        float v = red[(0 * 9 + r) * 64 + cc] + red[(1 * 9 + r) * 64 + cc] + red[(2 * 9 + r) * 64 + cc] + red[(3 * 9 + r) * 64 + cc];
        mod[(l * 9 + r) * 6144 + n0 + cc] = v + P.b_ada[l * 6144 + n0 + cc];
      }
      __syncthreads();
    }
  }
  __syncthreads();
  {
    float* tile = (float*)smem;
    for (int g = vb; g < 3104; g += nvb) {
      const int t = g * 4;
      const float* src; bf16* dst; int K, N, Npad, lt, isup = 0;
      if (t < 2176) { int i = t / 1088; lt = t % 1088; src = P.dn_w_in + (size_t)i * 1024 * DNP; dst = (bf16*)(P.ws + OFF_WIN + i * SZ_WIN); K = 1024; N = DNP; Npad = DNPAD; }
      else if (t < 2688) { int u = t - 2176; int i = u / 256; lt = u % 256; src = P.dn_w_out + (size_t)i * 1024 * 1024; dst = (bf16*)(P.ws + OFF_WOUT + i * SZ_WSQ); K = 1024; N = 1024; Npad = 1024; }
      else if (t < 3456) { int u = t - 2688; int i = u / 384; lt = u % 384; src = P.at_w_qkv + (size_t)i * 1024 * ATP; dst = (bf16*)(P.ws + OFF_WQKV + i * SZ_WQKV); K = 1024; N = ATP; Npad = ATP; }
      else if (t < 3968) { int u = t - 3456; int i = u / 256; lt = u % 256; src = P.at_w_o + (size_t)i * 1024 * 1024; dst = (bf16*)(P.ws + OFF_WO + i * SZ_WSQ); K = 1024; N = 1024; Npad = 1024; }
      else if (t < 9600) { int u = t - 3968; int i = u / 1408; lt = u % 1408; src = P.ffn_w_up + (size_t)i * 1024 * FF2; dst = (bf16*)(P.ws + OFF_WUP + i * SZ_WUP); K = 1024; N = FF2; Npad = FF2; isup = 1; }
      else { int u = t - 9600; int i = u / 704; lt = u % 704; src = P.ffn_w_down + (size_t)i * FF * 1024; dst = (bf16*)(P.ws + OFF_WDN + i * SZ_WDN); K = FF; N = 1024; Npad = 1024; }
      const int NT = Npad / 64;
      const int k0 = (lt / NT) * 64, n00 = (lt % NT) * 64;
      {
        const int r = tid >> 4, c4 = (tid & 15) * 4;
#pragma unroll
        for (int q = 0; q < 4; ++q) {
          const int n0 = n00 + 64 * q;
          const int ns0 = isup ? ((n0 & 255) < 128 ? (n0 >> 8) * 128 + (n0 & 127) : FF + (n0 >> 8) * 128 + (n0 & 127)) : n0;
#pragma unroll
          for (int i = 0; i < 4; ++i) {
            const int k = k0 + r + 16 * i, n = ns0 + c4;
            float4 v = make_float4(0.f, 0.f, 0.f, 0.f);
            if (n < N) v = nt_load4(src + (size_t)k * N + n);
            float* tp = tile + q * 4160 + (r + 16 * i) * 65 + c4;
            tp[0] = v.x; tp[1] = v.y; tp[2] = v.z; tp[3] = v.w;
          }
        }
      }
      __syncthreads();
      {
        const int n = tid >> 2, kq = tid & 3;
#pragma unroll
        for (int q = 0; q < 4; ++q) {
          unsigned pk[8];
#pragma unroll
          for (int e = 0; e < 8; ++e) pk[e] = pack2(tile[q * 4160 + (kq * 16 + 2 * e) * 65 + n], tile[q * 4160 + (kq * 16 + 2 * e + 1) * 65 + n]);
          uint4* dp = (uint4*)(dst + (size_t)(n00 + 64 * q + n) * K + k0 + kq * 16);
          dp[0] = make_uint4(pk[0], pk[1], pk[2], pk[3]);
          dp[1] = make_uint4(pk[4], pk[5], pk[6], pk[7]);
        }
      }
      __syncthreads();
    }
  }
  {
    bf16* Kc = (bf16*)(P.ws + OFF_KC);
    bf16* Vct = (bf16*)(P.ws + OFF_VCT);
    const int nth = nvb * 256;
    for (int idx = vb * 256 + tid; idx < 2097152; idx += nth) {
      {
        int d = idx & 63, s = (idx >> 6) & 511, kvh = (idx >> 15) & 3, bj = idx >> 17;
        Kc[idx] = f2bf(P.cache_k[((bj * 512 + s) * 4 + kvh) * 64 + d]);
      }
      {
        int s = idx & 511, d = (idx >> 9) & 63, kvh = (idx >> 15) & 3, bj = idx >> 17;
        Vct[idx] = f2bf(P.cache_v[((bj * 512 + s) * 4 + kvh) * 64 + d]);
      }
    }
  }
}

DI void phase_rowepi(const Params& P, int wv, int vb, int nvb, int mode, const float* ga, const float* modg, int gate_idx,
                     int do_h, const float* gb, const float* modn, int shift_idx, int scale_idx) {
  const int lane = get_tid(wv) & 63, wave = get_tid(wv) >> 6;
  const bf16* Y = (const bf16*)(P.ws + OFF_P);
  bf16* H = (bf16*)(P.ws + OFF_H);
  bf16* XBp = (bf16*)(P.ws + OFF_XB);
  const int nw = nvb * 4;
  for (int row = vb * 4 + wave; row < NTOK; row += nw) {
    const int c = cond_of_row(row);
    float x[16];
    float* xo = P.out + (size_t)row * 1024;
    if (mode == 0) {
      const float* src = row < NPR ? P.x_prompt + (size_t)row * 1024 : P.x_sample + (size_t)(row - NPR) * 1024;
#pragma unroll
      for (int j = 0; j < 4; ++j) {
        float4 v = nt_load4(src + j * 256 + lane * 4);
        x[4 * j] = v.x; x[4 * j + 1] = v.y; x[4 * j + 2] = v.z; x[4 * j + 3] = v.w;
      }
    } else {
      float y[16];
      float ss = 0.f;
#pragma unroll
      for (int j = 0; j < 4; ++j) {
        const uint2 yu = *(const uint2*)(Y + (size_t)row * 1024 + j * 256 + lane * 4);
        float4 v; v.x = bflo(yu.x); v.y = bfhi(yu.x); v.z = bflo(yu.y); v.w = bfhi(yu.y);
        y[4 * j] = v.x; y[4 * j + 1] = v.y; y[4 * j + 2] = v.z; y[4 * j + 3] = v.w;
        ss += v.x * v.x + v.y * v.y + v.z * v.z + v.w * v.w;
        const uint2 xu = *(const uint2*)(XBp + (size_t)row * 1024 + j * 256 + lane * 4);
        x[4 * j] = bflo(xu.x); x[4 * j + 1] = bfhi(xu.x); x[4 * j + 2] = bflo(xu.y); x[4 * j + 3] = bfhi(xu.y);
      }
#pragma unroll
      for (int o = 32; o > 0; o >>= 1) ss += shx(ss, o, lane);
      const float rstd = rsqrtf(ss * (1.f / 1024.f) + EPS);
#pragma unroll
      for (int j = 0; j < 4; ++j) {
        const int col = j * 256 + lane * 4;
        float4 g = *(const float4*)(ga + col);
        float4 gt = *(const float4*)(modg + c * 6144 + gate_idx * 1024 + col);
        x[4 * j] += gt.x * (y[4 * j] * rstd * g.x);
        x[4 * j + 1] += gt.y * (y[4 * j + 1] * rstd * g.y);
        x[4 * j + 2] += gt.z * (y[4 * j + 2] * rstd * g.z);
        x[4 * j + 3] += gt.w * (y[4 * j + 3] * rstd * g.w);
      }
    }
    if (do_h) {
#pragma unroll
      for (int j = 0; j < 4; ++j) *(uint2*)(XBp + (size_t)row * 1024 + j * 256 + lane * 4) = make_uint2(pack2(x[4 * j], x[4 * j + 1]), pack2(x[4 * j + 2], x[4 * j + 3]));
    } else {
#pragma unroll
      for (int j = 0; j < 4; ++j) nt_store4(xo + j * 256 + lane * 4, x[4 * j], x[4 * j + 1], x[4 * j + 2], x[4 * j + 3]);
    }
    if (do_h) {
      float ss = 0.f;
#pragma unroll
      for (int j = 0; j < 16; ++j) ss += x[j] * x[j];
#pragma unroll
      for (int o = 32; o > 0; o >>= 1) ss += shx(ss, o, lane);
      const float rstd = rsqrtf(ss * (1.f / 1024.f) + EPS);
#pragma unroll
      for (int j = 0; j < 4; ++j) {
        const int col = j * 256 + lane * 4;
        float4 g = *(const float4*)(gb + col);
        float4 sc = *(const float4*)(modn + c * 6144 + scale_idx * 1024 + col);
        float4 sh = *(const float4*)(modn + c * 6144 + shift_idx * 1024 + col);
        float h0 = x[4 * j] * rstd * g.x * (1.f + sc.x) + sh.x;
        float h1 = x[4 * j + 1] * rstd * g.y * (1.f + sc.y) + sh.y;
        float h2 = x[4 * j + 2] * rstd * g.z * (1.f + sc.z) + sh.z;
        float h3 = x[4 * j + 3] * rstd * g.w * (1.f + sc.w) + sh.w;
        *(uint2*)(H + (size_t)row * 1024 + col) = make_uint2(pack2(h0, h1), pack2(h2, h3));
      }
    }
  }
}

#define WAIT_VM(n) asm volatile("s_waitcnt vmcnt(%0)" ::"n"(n) : "memory")
#define RAW_BARRIER() do { asm volatile("s_waitcnt lgkmcnt(0)" ::: "memory"); __builtin_amdgcn_s_barrier(); } while (0)
using f32x4 = __attribute__((ext_vector_type(4))) float;
DI int g8_lds_byte(int r, int c) {
  int st = (r >> 4) * 2 + (c >> 5), rr = r & 15, cc = c & 31, ob = rr * 64 + cc * 2;
  return st * 1024 + (ob ^ (((ob >> 9) & 1) << 5));
}
DI void g8_stage_rc(int b, int& R, int& C) {
  int st = b / 1024, sb = b % 1024, swz = sb ^ (((sb >> 9) & 1) << 5);
  R = (st >> 1) * 16 + swz / 64; C = (st & 1) * 32 + (swz % 64) / 2;
}
DI void phase_gemm(int wv8, const bf16* __restrict__ A, int lda, const bf16* __restrict__ Bt, int K, int Npad, int N,
                   void* Cv, int ldc, int epi, const float* convw, const float* convb, bf16* halo, const Params& P, int jat, char* smem) {
  constexpr int HALF = 128, BK = 64, HT = HALF * BK;
  bf16* shm = (bf16*)smem;
  const int tid = get_tid(wv8) & 511;
  const int wid = tid >> 6, lane = tid & 63, wr = wid >> 2, wc = wid & 3, fr = lane & 15, fq = lane >> 4;
  (void)lda;
  const unsigned g8_ob = (unsigned)(fr * 64 + fq * 16), g8_obs = g8_ob ^ (((g8_ob >> 9) & 1u) << 5);
  const unsigned aA = (unsigned)(size_t)smem + (unsigned)(wr * 8192) + g8_obs;
  const unsigned aB = (unsigned)(size_t)smem + 65536u + (unsigned)(wc * 4096) + g8_obs;
  unsigned voff[2];
#pragma unroll
  for (int i = 0; i < 2; ++i) { int R_, C_; g8_stage_rc(tid * 16 + i * 8192, R_, C_); voff[i] = (unsigned)((R_ * K + C_) * 2); }
#define SA(b, hh) (shm + ((b) * 2 + (hh)) * HT)
#define SB(b, hh) (shm + (4 + (b) * 2 + (hh)) * HT)
#define STAGE(Pp, BASE, br, kt) do { const size_t _gu = (size_t)((BASE) + (long)(br) * K + (long)(kt) * BK);     \
    const char* _gb = (const char*)(((size_t)(unsigned)__builtin_amdgcn_readfirstlane((int)(_gu >> 32)) << 32) |   \
                                    (size_t)(unsigned)__builtin_amdgcn_readfirstlane((int)(unsigned)_gu));     \
    _Pragma("unroll") for (int _i = 0; _i < 2; ++_i)                                                                \
      __builtin_amdgcn_global_load_lds((const unsigned*)(_gb + voff[_i]),                                           \
        (unsigned*)((char*)(Pp) + tid * 16 + _i * 8192), 16, 0, 0); } while (0)
#define LDSR(dst, addr, off) asm volatile("ds_read_b128 %0, %1 offset:%2" : "=v"(dst) : "v"(addr), "n"(off) : "memory")
#define LDA(dst, b, hh) do {                                                                                        \
    LDSR(dst[0][0], aA, ((b) * 2 + (hh)) * 16384 + 0 * 2048 + 0);    LDSR(dst[0][1], aA, ((b) * 2 + (hh)) * 16384 + 0 * 2048 + 1024); \
    LDSR(dst[1][0], aA, ((b) * 2 + (hh)) * 16384 + 1 * 2048 + 0);    LDSR(dst[1][1], aA, ((b) * 2 + (hh)) * 16384 + 1 * 2048 + 1024); \
    LDSR(dst[2][0], aA, ((b) * 2 + (hh)) * 16384 + 2 * 2048 + 0);    LDSR(dst[2][1], aA, ((b) * 2 + (hh)) * 16384 + 2 * 2048 + 1024); \
    LDSR(dst[3][0], aA, ((b) * 2 + (hh)) * 16384 + 3 * 2048 + 0);    LDSR(dst[3][1], aA, ((b) * 2 + (hh)) * 16384 + 3 * 2048 + 1024); } while (0)
#define LDB(dst, b, hh) do {                                                                                        \
    LDSR(dst[0][0], aB, ((b) * 2 + (hh)) * 16384 + 0 * 2048 + 0);    LDSR(dst[0][1], aB, ((b) * 2 + (hh)) * 16384 + 0 * 2048 + 1024); \
    LDSR(dst[1][0], aB, ((b) * 2 + (hh)) * 16384 + 1 * 2048 + 0);    LDSR(dst[1][1], aB, ((b) * 2 + (hh)) * 16384 + 1 * 2048 + 1024); } while (0)
#define TIE_A(x) asm volatile("" : "+v"(x[0][0]), "+v"(x[0][1]), "+v"(x[1][0]), "+v"(x[1][1]), "+v"(x[2][0]), "+v"(x[2][1]), "+v"(x[3][0]), "+v"(x[3][1]) :: "memory")
#define TIE_B(x) asm volatile("" : "+v"(x[0][0]), "+v"(x[0][1]), "+v"(x[1][0]), "+v"(x[1][1]) :: "memory")
#define MMA(ai, bj, At_, Bt_) do { TIE_A(At_); TIE_B(Bt_); __builtin_amdgcn_s_setprio(1);                                                   \
    _Pragma("unroll") for (int m = 0; m < 4; ++m) _Pragma("unroll") for (int n = 0; n < 2; ++n) _Pragma("unroll") for (int k = 0; k < 2; ++k) \
      acc[ai][bj][m][n] = __builtin_amdgcn_mfma_f32_16x16x32_bf16(At_[m][k], Bt_[n][k], acc[ai][bj][m][n], 0, 0, 0); \
    __builtin_amdgcn_s_setprio(0); } while (0)
#define WAIT_V(n) asm volatile("s_waitcnt vmcnt(" #n ")" ::: "memory")
#define WAIT_L(n) asm volatile("s_waitcnt lgkmcnt(" #n ")" ::: "memory")
#define BAR __builtin_amdgcn_s_barrier()
#define SCHED __builtin_amdgcn_sched_barrier(0)
  const int nN = Npad / 256, ntiles = (NTOK / 256) * nN, nt = K / BK;
  for (int tile = blockIdx.x; tile < ntiles; tile += gridDim.x) {
    const int tmt = tile % 48, tnt = tile / 48;
    const int brow = tmt * 256, bcol = tnt * 256;
    f32x4 acc[2][2][4][2];
#pragma unroll
    for (int a = 0; a < 2; ++a)
#pragma unroll
      for (int b = 0; b < 2; ++b)
#pragma unroll
        for (int m = 0; m < 4; ++m)
#pragma unroll
          for (int n = 0; n < 2; ++n) acc[a][b][m][n] = f32x4{0.f, 0.f, 0.f, 0.f};
    bf16x8 At[4][2], B0[2][2], B1[2][2];
    WAIT_V(0);
    STAGE(SB(0, 0), Bt, bcol, 0); STAGE(SA(0, 0), A, brow, 0);
    STAGE(SB(0, 1), Bt, bcol + HALF, 0); STAGE(SA(0, 1), A, brow + HALF, 0);
    if (wr == 1) BAR;
    WAIT_V(4); BAR;
    STAGE(SB(1, 0), Bt, bcol, 1); STAGE(SA(1, 0), A, brow, 1); STAGE(SB(1, 1), Bt, bcol + HALF, 1);
    WAIT_V(6); BAR;
    for (int t = 0; t < nt - 2; t += 2) {
      LDB(B0, 0, 0); SCHED; LDA(At, 0, 0); STAGE(SA(1, 1), A, brow + HALF, t + 1);
      WAIT_L(8); BAR; WAIT_L(0); MMA(0, 0, At, B0); BAR; SCHED;
      LDB(B1, 0, 1); STAGE(SB(0, 0), Bt, bcol, t + 2);
      BAR; WAIT_L(0); MMA(0, 1, At, B1); BAR;
      LDA(At, 0, 1); STAGE(SA(0, 0), A, brow, t + 2);
      BAR; WAIT_L(0); MMA(1, 0, At, B0); BAR; SCHED;
      STAGE(SB(0, 1), Bt, bcol + HALF, t + 2);
      WAIT_V(6); BAR; MMA(1, 1, At, B1); BAR;
      LDB(B0, 1, 0); SCHED; LDA(At, 1, 0); STAGE(SA(0, 1), A, brow + HALF, t + 2);
      WAIT_L(8); BAR; WAIT_L(0); MMA(0, 0, At, B0); BAR; SCHED;
      LDB(B1, 1, 1); STAGE(SB(1, 0), Bt, bcol, t + 3);
      BAR; WAIT_L(0); MMA(0, 1, At, B1); BAR;
      LDA(At, 1, 1); STAGE(SA(1, 0), A, brow, t + 3);
      BAR; WAIT_L(0); MMA(1, 0, At, B0); BAR; SCHED;
      STAGE(SB(1, 1), Bt, bcol + HALF, t + 3);
      WAIT_V(6); BAR; MMA(1, 1, At, B1); BAR;
    }
    { LDB(B0, 0, 0); LDA(At, 0, 0); STAGE(SA(1, 1), A, brow + HALF, nt - 1);
      BAR; WAIT_L(0); MMA(0, 0, At, B0); BAR;
      LDB(B1, 0, 1); BAR; WAIT_L(0); MMA(0, 1, At, B1); BAR;
      LDA(At, 0, 1); WAIT_V(4); BAR; WAIT_L(0); MMA(1, 0, At, B0); MMA(1, 1, At, B1); BAR; }
    { LDB(B0, 1, 0); LDA(At, 1, 0); WAIT_V(2); BAR; WAIT_L(0); MMA(0, 0, At, B0); BAR;
      LDB(B1, 1, 1); WAIT_V(0); BAR; WAIT_L(0); MMA(0, 1, At, B1); BAR;
      LDA(At, 1, 1); BAR; WAIT_L(0); MMA(1, 0, At, B0); MMA(1, 1, At, B1); BAR; }
    if (wr == 0) BAR;
    if (epi >= 3) {
      bf16* Plw = (bf16*)smem;
      int pb = (wr * 64 + fq * 4) * 268 + wc * 32 + fr;
      asm volatile("" : "+v"(pb));
#pragma unroll
      for (int ai = 0; ai < 2; ++ai)
#pragma unroll
        for (int bj = 0; bj < 2; ++bj)
#pragma unroll
          for (int m = 0; m < 4; ++m)
#pragma unroll
            for (int n = 0; n < 2; ++n)
#pragma unroll
              for (int jj = 0; jj < 4; ++jj)
                Plw[pb + (ai * HALF + m * 16 + jj) * 268 + bj * HALF + n * 16] = f2bf(acc[ai][bj][m][n][jj]);
      __syncthreads();
    }
    if (epi == 4) {
      bf16* Pl = (bf16*)smem;
      const int nb = tnt, mt = tmt;
      {
        int tidq = tid;
        asm volatile("" : "+v"(tidq));
        const bool smp = mt >= 16;
        const int sq = smp ? 16 + ((mt - 16) >> 2) : mt;
        const int ssq = seq_start(sq), lenq = seq_len(sq);
        const int tb = brow - ssq;
        if (nb < 5) {
          const int row = tidq >> 1, hsel = tidq & 1;
          const int tpos = tb + row;
          const float scl = nb < 4 ? 0.125f : 1.f;
#pragma unroll 1
          for (int hh = 0; hh < 4; ++hh) {
            const int hl = hh >> 1, hb = hh & 1;
            const int colh = hsel * 128 + hl * 64 + hb * 32;
            const bf16* src = Pl + row * 268 + colh;
            float v[32];
#pragma unroll
            for (int c8 = 0; c8 < 4; ++c8) {
              const uint2 ua_ = *(const uint2*)(src + c8 * 8), ub_ = *(const uint2*)(src + c8 * 8 + 4);
              const uint4 u = make_uint4(ua_.x, ua_.y, ub_.x, ub_.y);
              v[c8 * 8 + 0] = bflo(u.x); v[c8 * 8 + 1] = bfhi(u.x); v[c8 * 8 + 2] = bflo(u.y); v[c8 * 8 + 3] = bfhi(u.y);
              v[c8 * 8 + 4] = bflo(u.z); v[c8 * 8 + 5] = bfhi(u.z); v[c8 * 8 + 6] = bflo(u.w); v[c8 * 8 + 7] = bfhi(u.w);
            }
            if (nb == 4 && !smp) {
              float* ck = P.out + OUT_CK + ((size_t)((sq * 2 + jat) * 256 + tpos)) * 256 + colh;
#pragma unroll
              for (int c4 = 0; c4 < 8; ++c4) *(float4*)(ck + c4 * 4) = make_float4(v[c4 * 4], v[c4 * 4 + 1], v[c4 * 4 + 2], v[c4 * 4 + 3]);
            }
            float o[32];
            const float pp = (float)(hb ? (tpos & 63) : (tpos >> 6));
#pragma unroll
            for (int f = 0; f < 16; ++f) {
              float c_ = 1.f, s_ = 0.f;
              if (smp) { const float ang = pp * exp2f(-(float)f * (13.287712379549449f / 16.f)); c_ = __cosf(ang); s_ = __sinf(ang); }
              const float x1 = v[f], x2 = v[16 + f];
              o[f] = x1 * c_ - x2 * s_;
              o[16 + f] = x1 * s_ + x2 * c_;
            }
            bf16* dst = nb < 4 ? (bf16*)(P.ws + OFF_AQ) + (size_t)(brow + row) * 1024 + nb * 256 + colh
                               : (bf16*)(P.ws + OFF_AK) + (size_t)(brow + row) * 256 + colh;
#pragma unroll
            for (int c8 = 0; c8 < 4; ++c8)
              *(uint4*)(dst + c8 * 8) = make_uint4(pack2(o[c8 * 8] * scl, o[c8 * 8 + 1] * scl), pack2(o[c8 * 8 + 2] * scl, o[c8 * 8 + 3] * scl),
                                                   pack2(o[c8 * 8 + 4] * scl, o[c8 * 8 + 5] * scl), pack2(o[c8 * 8 + 6] * scl, o[c8 * 8 + 7] * scl));
          }
        } else {
          const int c = tidq & 255, rh = tidq >> 8;
          bf16* vt = (bf16*)(P.ws + OFF_AVT) + (size_t)ssq * 256 + (size_t)c * lenq + tb + rh * 128;
#pragma unroll 4
          for (int g8 = 0; g8 < 16; ++g8) {
            unsigned short e[8];
#pragma unroll
            for (int q = 0; q < 8; ++q) e[q] = Pl[(rh * 128 + g8 * 8 + q) * 268 + c];
            *(uint4*)(vt + g8 * 8) = make_uint4((unsigned)e[0] | ((unsigned)e[1] << 16), (unsigned)e[2] | ((unsigned)e[3] << 16),
                                                 (unsigned)e[4] | ((unsigned)e[5] << 16), (unsigned)e[6] | ((unsigned)e[7] << 16));
          }
          if (!smp) {
            const int row = tidq >> 1, hsel = tidq & 1;
            float* cv = P.out + OUT_CV + ((size_t)((sq * 2 + jat) * 256 + tb + row)) * 256 + hsel * 128;
            const bf16* src = Pl + row * 268 + hsel * 128;
#pragma unroll 4
            for (int c8 = 0; c8 < 16; ++c8) {
              const uint2 ua_ = *(const uint2*)(src + c8 * 8), ub_ = *(const uint2*)(src + c8 * 8 + 4);
              const uint4 u = make_uint4(ua_.x, ua_.y, ub_.x, ub_.y);
              *(float4*)(cv + c8 * 8) = make_float4(bflo(u.x), bfhi(u.x), bflo(u.y), bfhi(u.y));
              *(float4*)(cv + c8 * 8 + 4) = make_float4(bflo(u.z), bfhi(u.z), bflo(u.w), bfhi(u.w));
            }
          }
        }
      }
      __syncthreads();
      continue;
    }
    if (epi == 3) {
      bf16* Pl = (bf16*)smem;
      const int nb = tnt, mt = tmt;
      {
        const int fl = tid & 127, strip = tid >> 7, r0 = strip * 64;
        const int f = nb * 128 + fl;
        const float* cw = (const float*)convw;
        const float* cbv = (const float*)convb;
        const float wa0 = cw[f], wa1 = cw[FF2 + f], wa2 = cw[2 * FF2 + f], ba = cbv[f];
        const float wb0 = cw[FF + f], wb1 = cw[FF2 + FF + f], wb2 = cw[2 * FF2 + FF + f], bb = cbv[FF + f];
        const bool smp = mt >= 16;
        const int qd = (mt - 16) & 3;
        const bool defer0 = smp && qd != 0, defer255 = smp && qd != 3;
        bf16* actp = (bf16*)Cv + (size_t)brow * FF + f;
        float pa = 0.f, pb = 0.f;
        if (r0 > 0) { pa = bf2f(Pl[(r0 - 1) * 268 + fl]); pb = bf2f(Pl[(r0 - 1) * 268 + 128 + fl]); }
        float ca = bf2f(Pl[r0 * 268 + fl]), cb2 = bf2f(Pl[r0 * 268 + 128 + fl]);
#pragma unroll 4
        for (int rr = r0; rr < r0 + 64; ++rr) {
          float na = 0.f, nb2 = 0.f;
          if (rr + 1 < 256) { na = bf2f(Pl[(rr + 1) * 268 + fl]); nb2 = bf2f(Pl[(rr + 1) * 268 + 128 + fl]); }
          const float ua = wa0 * pa + wa1 * ca + wa2 * na + ba;
          const float ub = wb0 * pb + wb1 * cb2 + wb2 * nb2 + bb;
          const float o = ua / (1.f + __expf(-ua)) * ub;
          if (!((rr == 0 && defer0) || (rr == 255 && defer255))) actp[(size_t)rr * FF] = f2bf(o);
          pa = ca; ca = na; pb = cb2; cb2 = nb2;
        }
        if (tid < 128) {
          const int hr = tid >> 5, ch = tid & 31;
          const int srcrow = hr < 2 ? hr : 252 + hr;
          *(uint4*)(halo + ((size_t)(mt * 22 + nb) * 4 + hr) * 256 + ch * 8) = make_uint4(((const uint2*)(Pl + srcrow * 268 + ch * 8))[0].x, ((const uint2*)(Pl + srcrow * 268 + ch * 8))[0].y, ((const uint2*)(Pl + srcrow * 268 + ch * 8))[1].x, ((const uint2*)(Pl + srcrow * 268 + ch * 8))[1].y);
        }
      }
      __syncthreads();
      continue;
    }
#pragma unroll
    for (int ai = 0; ai < 2; ++ai)
#pragma unroll
      for (int bj = 0; bj < 2; ++bj)
#pragma unroll
        for (int n = 0; n < 2; ++n) {
          const int col = bcol + bj * HALF + wc * 32 + n * 16 + fr;
          if (col < N) {
#pragma unroll
            for (int m = 0; m < 4; ++m)
#pragma unroll
              for (int jj = 0; jj < 4; ++jj) {
                const size_t off = (size_t)(brow + ai * HALF + wr * 64 + m * 16 + fq * 4 + jj) * ldc + col;
                if (epi == 0) ((bf16*)Cv)[off] = f2bf(acc[ai][bj][m][n][jj]);
                else ((float*)Cv)[off] = acc[ai][bj][m][n][jj];
              }
          }
        }
  }
#undef SA
#undef SB
#undef STAGE
#undef LDA
#undef LDB
#undef LDSR
#undef TIE_A
#undef TIE_B
#undef MMA
#undef WAIT_V
#undef WAIT_L
#undef BAR
#undef SCHED
}

DI void phase_dnconv(const Params& P, int wv, int vb, int nvb, int j) {
  const int tid = get_tid(wv), lane = tid & 63;
  const bf16* proj = (const bf16*)(P.ws + OFF_P);
  bf16* Q = (bf16*)(P.ws + OFF_DQ);
  bf16* Kb = (bf16*)(P.ws + OFF_DK);
  bf16* V = (bf16*)(P.ws + OFF_DV);
  const int cb = 4 * tid;
  float w[3][3][4];
#pragma unroll
  for (int sec = 0; sec < 3; ++sec)
#pragma unroll
    for (int k = 0; k < 3; ++k) {
      float4 v = *(const float4*)(P.dn_conv_w + (size_t)j * 9216 + k * 3072 + sec * 1024 + cb);
      w[sec][k][0] = v.x; w[sec][k][1] = v.y; w[sec][k][2] = v.z; w[sec][k][3] = v.w;
    }
  for (int run = vb; run < NTOK / 8; run += nvb) {
    const int row0 = run * 8;
    const int s = seq_of_row(row0), ss = seq_start(s), se = ss + seq_len(s);
    float prev[3][4], cur[3][4], nxt[3][4];
#pragma unroll
    for (int sec = 0; sec < 3; ++sec) {
      uint2 u = make_uint2(0u, 0u);
      if (row0 - 1 >= ss) u = *(const uint2*)(proj + (size_t)(row0 - 1) * DNP + sec * 1024 + cb);
      prev[sec][0] = bflo(u.x); prev[sec][1] = bfhi(u.x); prev[sec][2] = bflo(u.y); prev[sec][3] = bfhi(u.y);
      uint2 v = *(const uint2*)(proj + (size_t)row0 * DNP + sec * 1024 + cb);
      cur[sec][0] = bflo(v.x); cur[sec][1] = bfhi(v.x); cur[sec][2] = bflo(v.y); cur[sec][3] = bfhi(v.y);
    }
#pragma unroll 1
    for (int t = 0; t < 8; ++t) {
      const int row = row0 + t;
#pragma unroll
      for (int sec = 0; sec < 3; ++sec) {
        uint2 u = make_uint2(0u, 0u);
        if (row + 1 < se) u = *(const uint2*)(proj + (size_t)(row + 1) * DNP + sec * 1024 + cb);
        nxt[sec][0] = bflo(u.x); nxt[sec][1] = bfhi(u.x); nxt[sec][2] = bflo(u.y); nxt[sec][3] = bfhi(u.y);
      }
      float val[3][4];
#pragma unroll
      for (int sec = 0; sec < 3; ++sec)
#pragma unroll
        for (int e = 0; e < 4; ++e) {
          float y = w[sec][0][e] * prev[sec][e] + w[sec][1][e] * cur[sec][e] + w[sec][2][e] * nxt[sec][e];
          val[sec][e] = y / (1.f + __expf(-y));
        }
      float sq = val[0][0] * val[0][0] + val[0][1] * val[0][1] + val[0][2] * val[0][2] + val[0][3] * val[0][3];
      float sk = val[1][0] * val[1][0] + val[1][1] * val[1][1] + val[1][2] * val[1][2] + val[1][3] * val[1][3];
#pragma unroll
      for (int o = 16; o > 0; o >>= 1) { sq += shx(sq, o, lane); sk += shx(sk, o, lane); }
      const float rq = rsqrtf(sq + EPS) * 0.08838834764831845f;
      const float rk = rsqrtf(sk + EPS);
      *(uint2*)(Q + (size_t)row * 1024 + cb) = make_uint2(pack2(val[0][0] * rq, val[0][1] * rq), pack2(val[0][2] * rq, val[0][3] * rq));
      *(uint2*)(Kb + (size_t)row * 1024 + cb) = make_uint2(pack2(val[1][0] * rk, val[1][1] * rk), pack2(val[1][2] * rk, val[1][3] * rk));
      *(uint2*)(V + (size_t)row * 1024 + cb) = make_uint2(pack2(val[2][0], val[2][1]), pack2(val[2][2], val[2][3]));
#pragma unroll
      for (int sec = 0; sec < 3; ++sec)
#pragma unroll
        for (int e = 0; e < 4; ++e) { prev[sec][e] = cur[sec][e]; cur[sec][e] = nxt[sec][e]; }
    }
  }
}

DI void phase_dnprep(const Params& P, int wv, int vb, int nvb, int j, char* smem) {
  const int tid0 = get_tid(wv);
  const bf16* proj = (const bf16*)(P.ws + OFF_P);
  const bf16* Q = (const bf16*)(P.ws + OFF_DQ);
  const bf16* Kb = (const bf16*)(P.ws + OFF_DK);
  bf16* QKB = (bf16*)(P.ws + OFF_QK);
  bf16* TB = (bf16*)(P.ws + OFF_TB);
  float* GC = (float*)(P.ws + OFF_GC);
  float* BETA = (float*)(P.ws + OFF_BETA);
  bf16* ksm = (bf16*)smem;
  bf16* qsm = (bf16*)(smem + 17408);
  float* L0 = (float*)(smem + 34816);
  float* L1 = (float*)(smem + 52224);
  float* gcs = (float*)(smem + 69632);
  float* betas = (float*)(smem + 70144);
  for (int it = vb; it < 1536; it += nvb) {
    int tid = tid0;
    asm volatile("" : "+v"(tid));
    const int lane = tid & 63, w = tid >> 6, r = lane & 31, h_ = lane >> 5;
    const int hd = it & 7, gch = it >> 3;
    const int row0 = gch * 64;
    const int s = seq_of_row(row0), ss = seq_start(s), nch = seq_len(s) >> 6;
    const int cn = (row0 - ss) >> 6;
    const int item0 = ((ss / 64 + cn) * 8 + hd) * 2 + 0;
    const int item1 = ((ss / 64 + (nch - 1 - cn)) * 8 + hd) * 2 + 1;
#pragma unroll
    for (int e = 0; e < 4; ++e) {
      const int p = tid + 256 * e, rr = p >> 4, cp = p & 15;
      *(uint4*)(ksm + rr * 136 + cp * 8) = *(const uint4*)(Kb + (size_t)(row0 + rr) * 1024 + hd * 128 + cp * 8);
      *(uint4*)(qsm + rr * 136 + cp * 8) = *(const uint4*)(Q + (size_t)(row0 + rr) * 1024 + hd * 128 + cp * 8);
    }
    if (tid < 128) {
      const int d = tid >> 6, i = tid & 63;
      const int tn = d ? 63 - i : i;
      const size_t row = row0 + tn;
      const float a = bf2f(proj[row * DNP + 4096 + d * 8 + hd]);
      const float b = bf2f(proj[row * DNP + 4112 + d * 8 + hd]);
      const float Aa = __expf(P.dn_a_log[j * 16 + d * 8 + hd]);
      const float xx = a + P.dn_dt_bias[j * 16 + d * 8 + hd];
      const float sp = xx > 20.f ? xx : __logf(1.f + __expf(xx));
      float g = -Aa * sp;
      const float beta = 1.f / (1.f + __expf(-b));
#pragma unroll
      for (int o = 1; o < 64; o <<= 1) { float t = __int_as_float(__builtin_amdgcn_ds_bpermute(((i >= o) ? i - o : i) << 2, __float_as_int(g))); if (i >= o) g += t; }
      gcs[d * 64 + i] = g; betas[d * 64 + i] = beta;
      const int item = d ? item1 : item0;
      GC[item * 64 + i] = g; BETA[item * 64 + i] = beta;
    }
    __syncthreads();
    {
      const int ti = w >> 1, tj = w & 1;
      f32x16 kk, qk;
#pragma unroll
      for (int i = 0; i < 16; ++i) { kk[i] = 0.f; qk[i] = 0.f; }
#pragma unroll
      for (int ks = 0; ks < 8; ++ks) {
        bf16x8 ak = *(const bf16x8*)(ksm + (ti * 32 + r) * 136 + ks * 16 + h_ * 8);
        bf16x8 aq = *(const bf16x8*)(qsm + (ti * 32 + r) * 136 + ks * 16 + h_ * 8);
        bf16x8 bk = *(const bf16x8*)(ksm + (tj * 32 + r) * 136 + ks * 16 + h_ * 8);
        kk = MFMA(ak, bk, kk);
        qk = MFMA(aq, bk, qk);
      }
      __syncthreads();
      bf16* T0 = ksm; bf16* QK0 = ksm + 4096; bf16* T1 = qsm; bf16* QK1 = qsm + 4096;
      (void)T0; (void)T1;
      const int jn = tj * 32 + r;
      const float gj0 = gcs[jn], gj1 = gcs[64 + 63 - jn];
#pragma unroll
      for (int q4 = 0; q4 < 4; ++q4) {
        const int ib = ti * 32 + 8 * q4 + 4 * h_;
#pragma unroll
        for (int e = 0; e < 4; ++e) {
          const int ii = 4 * q4 + e;
          const int i = ib + e;
          {
            const float ex = (i >= jn) ? __expf(gcs[i] - gj0) : 0.f;
            L0[i * 68 + jn] = (i > jn) ? betas[i] * kk[ii] * ex : 0.f;
            QK0[i * 64 + jn] = f2bf(qk[ii] * ex);
          }
          {
            const int is = 63 - i, js = 63 - jn;
            const float ex = (is >= js) ? __expf(gcs[64 + is] - gj1) : 0.f;
            L1[is * 68 + js] = (is > js) ? betas[64 + is] * kk[ii] * ex : 0.f;
            QK1[is * 64 + js] = f2bf(qk[ii] * ex);
          }
          __builtin_amdgcn_sched_barrier(0);
        }
      }
    }
    __syncthreads();
    if (w < 2) {
      const float* L = w ? L1 : L0;
      bf16* TL = w ? qsm : ksm;
      float x[64];
      const float lanef = (float)lane;
#pragma unroll
      for (int i = 0; i < 64; ++i) {
        float a0 = fmaxf(0.f, 1.f - fabsf(lanef - (float)i)), a1 = 0.f, a2 = 0.f, a3 = 0.f;
#pragma unroll
        for (int j4 = 0; j4 < (i + 3) / 4; ++j4) {
          const float4 l = *(const float4*)(L + i * 68 + j4 * 4);
          if (j4 * 4 + 0 < i) a0 -= l.x * x[j4 * 4 + 0];
          if (j4 * 4 + 1 < i) a1 -= l.y * x[j4 * 4 + 1];
          if (j4 * 4 + 2 < i) a2 -= l.z * x[j4 * 4 + 2];
          if (j4 * 4 + 3 < i) a3 -= l.w * x[j4 * 4 + 3];
        }
        const float acc = (a0 + a1) + (a2 + a3);
        x[i] = acc;
        TL[i * 64 + lane] = f2bf(acc);
        __builtin_amdgcn_sched_barrier(0);
      }
    }
    __syncthreads();
#pragma unroll
    for (int e = 0; e < 2; ++e) {
      const int p = tid + 256 * e;
      *(uint4*)(TB + (size_t)item0 * 4096 + p * 8) = *(const uint4*)(ksm + p * 8);
      *(uint4*)(QKB + (size_t)item0 * 4096 + p * 8) = *(const uint4*)(ksm + 4096 + p * 8);
      *(uint4*)(TB + (size_t)item1 * 4096 + p * 8) = *(const uint4*)(qsm + p * 8);
      *(uint4*)(QKB + (size_t)item1 * 4096 + p * 8) = *(const uint4*)(qsm + 4096 + p * 8);
    }
    __syncthreads();
  }
}

#define SC_LDS2(dst, addr, o0) asm volatile("ds_read2_b64 %0, %1 offset0:%2 offset1:%3" : "=v"(dst) : "v"(addr), "n"(o0), "n"((o0) + 2) : "memory")
#define SC_G8(fa, a0, a1, ob) do {                                                                                  \
    SC_LDS2(fa[0], a0, (ob) + 0);  SC_LDS2(fa[1], a1, (ob) + 0);  SC_LDS2(fa[2], a0, (ob) + 4);  SC_LDS2(fa[3], a1, (ob) + 4);  \
    SC_LDS2(fa[4], a0, (ob) + 8);  SC_LDS2(fa[5], a1, (ob) + 8);  SC_LDS2(fa[6], a0, (ob) + 12); SC_LDS2(fa[7], a1, (ob) + 12); } while (0)
#define SC_TIE8(fa) asm volatile("s_waitcnt lgkmcnt(0)" : "+v"(fa[0]), "+v"(fa[1]), "+v"(fa[2]), "+v"(fa[3]), "+v"(fa[4]), "+v"(fa[5]), "+v"(fa[6]), "+v"(fa[7]) :: "memory")
#define SC_G6(fa, a0, a1) do { SC_LDS2(fa[0], a0, 0); SC_LDS2(fa[1], a1, 0); SC_LDS2(fa[2], a0, 4); SC_LDS2(fa[3], a1, 4); \
    SC_LDS2(fa[4], a1, 8); SC_LDS2(fa[5], a1, 12); } while (0)
#define SC_TIE6(fa) asm volatile("s_waitcnt lgkmcnt(0)" : "+v"(fa[0]), "+v"(fa[1]), "+v"(fa[2]), "+v"(fa[3]), "+v"(fa[4]), "+v"(fa[5]) :: "memory")
#define SC_G8T(fa, b0, b1, b2, b3, ob) do {                                                                         \
    SC_LDS2(fa[0], b0, (ob) + 0); SC_LDS2(fa[1], b1, (ob) + 0); SC_LDS2(fa[2], b2, (ob) + 0); SC_LDS2(fa[3], b3, (ob) + 0);     \
    SC_LDS2(fa[4], b0, (ob) + 4); SC_LDS2(fa[5], b1, (ob) + 4); SC_LDS2(fa[6], b2, (ob) + 4); SC_LDS2(fa[7], b3, (ob) + 4); } while (0)
DI void phase_dnscan(const Params& P, int wv, int vb, int nvb, int j, char* smem) {
  const int tid0 = get_tid(wv);
  bf16* obuf = (bf16*)(P.ws + OFF_P);
  const bf16* Q = (const bf16*)(P.ws + OFF_DQ);
  const bf16* Kb = (const bf16*)(P.ws + OFF_DK);
  const bf16* V = (const bf16*)(P.ws + OFF_DV);
  const bf16* QKB = (const bf16*)(P.ws + OFF_QK);
  const bf16* TB = (const bf16*)(P.ws + OFF_TB);
  const float* GC = (const float*)(P.ws + OFF_GC);
  const float* BETA = (const float*)(P.ws + OFF_BETA);
  bf16* ksm = (bf16*)smem;
  bf16* qsm = (bf16*)(smem + 16896);
  bf16* kT = (bf16*)(smem + 33792);
  bf16* Tsm = (bf16*)(smem + 51200);
  bf16* QKsm = (bf16*)(smem + 59904);
  float* egc = (float*)(smem + 68608);
  float* edec = (float*)(smem + 68864);
  float* betas = (float*)(smem + 69120);
  int it0 = vb, it1 = 384, itstep = nvb, lp = 0;
  char* base8 = smem;
  if (nvb >= 512) {
    const int bb = vb >> 1, sb = vb & 1;
    itstep = 1;
    if (bb < 128) { it0 = bb; it1 = bb + 1; lp = sb ? 2 : 1; base8 = smem - sb * LDS_BYTES; }
    else if (bb < 256) { it0 = 128 + 2 * (bb - 128) + sb; it1 = it0 + 1; }
    else { it0 = 0; it1 = 0; }
  }
  for (int it = it0; it < it1; it += itstep) {
    const int w = tid0 >> 6;
    int tidA = tid0;
    asm volatile("" : "+v"(tidA));
    const int dv0 = 32 * w + (tidA & 31), h0_ = (tidA & 63) >> 5;
    int s, rem;
    if (it < 128) { s = 16 + (it >> 4); rem = it & 15; } else { s = (it - 128) >> 4; rem = (it - 128) & 15; }
    const int hd = rem >> 1, d = rem & 1;
    const int ss = seq_start(s), len = seq_len(s), nch = len >> 6, gch0 = ss >> 6;
    f32x16 S[4];
    if (s >= 16 && lp != 2) {
      const float* src = P.state_delta + ((size_t)((((s - 16) * 2 + j) * 2 + d) * 8 + hd)) * 16384;
#pragma unroll
      for (int mt = 0; mt < 4; ++mt)
#pragma unroll
        for (int i = 0; i < 16; ++i) S[mt][i] = src[(32 * mt + crow(i, h0_)) * 128 + dv0];
    } else {
#pragma unroll
      for (int mt = 0; mt < 4; ++mt)
#pragma unroll
        for (int i = 0; i < 16; ++i) S[mt][i] = 0.f;
    }
    const int nsteps = lp ? nch + 1 : nch;
    unsigned vpn[2][8];
#pragma unroll
    for (int tt = 0; tt < 2; ++tt)
#pragma unroll
      for (int e = 0; e < 8; ++e) vpn[tt][e] = 0u;
#pragma unroll 1
    for (int t = 0; t < nsteps; ++t) {
      int tid = tid0;
      asm volatile("" : "+v"(tid));
      const int lane = tid & 63, r = lane & 31, h_ = lane >> 5;
      const int dv = 32 * w + r;
      char* sbL = lp ? base8 + (t & 1) * LDS_BYTES : smem;
      char* sbC = lp ? base8 + ((t + 1) & 1) * LDS_BYTES : smem;
      if (lp != 1 && t < nch) {
        const int cd = t;
        const int item = ((gch0 + cd) * 8 + hd) * 2 + d;
        bf16* ksmL = (bf16*)sbL; bf16* qsmL = (bf16*)(sbL + 16896); bf16* kTL = (bf16*)(sbL + 33792);
        bf16* TsmL = (bf16*)(sbL + 51200); bf16* QKsmL = (bf16*)(sbL + 59904);
        float* egcL = (float*)(sbL + 68608); float* edecL = (float*)(sbL + 68864); float* betasL = (float*)(sbL + 69120);
      uint4 kvr[4], qvr[4], tvr[2], qkr[2];
#pragma unroll
      for (int e = 0; e < 4; ++e) {
        const int p = tid + 256 * e, i = p >> 4, cp = p & 15;
        const int row = ss + (d ? len - 1 - (64 * cd + i) : 64 * cd + i);
        kvr[e] = *(const uint4*)(Kb + (size_t)row * 1024 + hd * 128 + cp * 8);
        qvr[e] = *(const uint4*)(Q + (size_t)row * 1024 + hd * 128 + cp * 8);
      }
#pragma unroll
      for (int e = 0; e < 2; ++e) {
        const int p = tid + 256 * e, i = p >> 3, cp = p & 7;
        tvr[e] = *(const uint4*)(TB + (size_t)item * 4096 + i * 64 + cp * 8);
        qkr[e] = *(const uint4*)(QKB + (size_t)item * 4096 + i * 64 + cp * 8);
      }
      __builtin_amdgcn_sched_barrier(0);
#pragma unroll
      for (int e = 0; e < 4; ++e) {
        const int p = tid + 256 * e, i = p >> 4, cp = p & 15;
        const uint4 kv = kvr[e], qv = qvr[e];
        *(uint2*)(ksmL + i * 132 + cp * 8) = make_uint2(kv.x, kv.y);
        *(uint2*)(ksmL + i * 132 + cp * 8 + 4) = make_uint2(kv.z, kv.w);
        *(uint2*)(qsmL + i * 132 + cp * 8) = make_uint2(qv.x, qv.y);
        *(uint2*)(qsmL + i * 132 + cp * 8 + 4) = make_uint2(qv.z, qv.w);
        bf16* kt = kTL + (cp * 8) * 68 + i;
        kt[0 * 68] = (bf16)(kv.x & 0xffffu); kt[1 * 68] = (bf16)(kv.x >> 16);
        kt[2 * 68] = (bf16)(kv.y & 0xffffu); kt[3 * 68] = (bf16)(kv.y >> 16);
        kt[4 * 68] = (bf16)(kv.z & 0xffffu); kt[5 * 68] = (bf16)(kv.z >> 16);
        kt[6 * 68] = (bf16)(kv.w & 0xffffu); kt[7 * 68] = (bf16)(kv.w >> 16);
      }
#pragma unroll
      for (int e = 0; e < 2; ++e) {
        const int p = tid + 256 * e, i = p >> 3, cp = p & 7;
        const uint4 tv = tvr[e], qv = qkr[e];
        *(uint2*)(TsmL + i * 68 + cp * 8) = make_uint2(tv.x, tv.y);
        *(uint2*)(TsmL + i * 68 + cp * 8 + 4) = make_uint2(tv.z, tv.w);
        *(uint2*)(QKsmL + i * 68 + cp * 8) = make_uint2(qv.x, qv.y);
        *(uint2*)(QKsmL + i * 68 + cp * 8 + 4) = make_uint2(qv.z, qv.w);
      }
      {
        const float glastL_ = GC[item * 64 + 63];
        if (tid < 64) {
          const float gc = GC[item * 64 + tid];
          egcL[tid] = __expf(gc); edecL[tid] = __expf(glastL_ - gc); betasL[tid] = BETA[item * 64 + tid];
        }
      }
      }
      const int cd = lp ? t - 1 : t;
      const bool docomp = (lp != 2) && cd >= 0 && cd < nch;
      unsigned vp[2][8];
#pragma unroll
      for (int tt = 0; tt < 2; ++tt)
#pragma unroll
        for (int e = 0; e < 8; ++e) vp[tt][e] = vpn[tt][e];
      unsigned vlo[16], vhi[16];
      const bool vld = (lp != 2) && t < nch;
      if (vld) {
        const int rsv = d ? -1024 : 1024;
        const int rowbv = ss + (d ? len - 1 - 64 * t : 64 * t);
        const bf16* Vbv = V + (size_t)rowbv * 1024 + hd * 128;
#pragma unroll
        for (int tt = 0; tt < 2; ++tt)
#pragma unroll
          for (int e = 0; e < 8; ++e) {
            const int t0 = 32 * tt + crow(2 * e, h_);
            const bf16* p0 = Vbv + t0 * rsv + dv;
            const bf16* p1 = Vbv + (t0 + 1) * rsv + dv;
            asm volatile("global_load_ushort %0, %1, off" : "=v"(vlo[tt * 8 + e]) : "v"(p0) : "memory");
            asm volatile("global_load_ushort %0, %1, off" : "=v"(vhi[tt * 8 + e]) : "v"(p1) : "memory");
          }
      }
#define V_COLLECT()                                                                                                 \
      do {                                                                                                          \
        asm volatile("s_waitcnt vmcnt(0)" : "+v"(vlo[0]), "+v"(vlo[1]), "+v"(vlo[2]), "+v"(vlo[3]), "+v"(vlo[4]), "+v"(vlo[5]), "+v"(vlo[6]), "+v"(vlo[7]), \
                     "+v"(vlo[8]), "+v"(vlo[9]), "+v"(vlo[10]), "+v"(vlo[11]), "+v"(vlo[12]), "+v"(vlo[13]), "+v"(vlo[14]), "+v"(vlo[15]) :: "memory"); \
        asm volatile("" : "+v"(vhi[0]), "+v"(vhi[1]), "+v"(vhi[2]), "+v"(vhi[3]), "+v"(vhi[4]), "+v"(vhi[5]), "+v"(vhi[6]), "+v"(vhi[7]), \
                     "+v"(vhi[8]), "+v"(vhi[9]), "+v"(vhi[10]), "+v"(vhi[11]), "+v"(vhi[12]), "+v"(vhi[13]), "+v"(vhi[14]), "+v"(vhi[15]) :: "memory"); \
        _Pragma("unroll") for (int k_ = 0; k_ < 16; ++k_) vpn[k_ >> 3][k_ & 7] = vlo[k_] | (vhi[k_] << 16);         \
      } while (0)
      if (!lp) {
        __syncthreads();
        if (vld) {
          V_COLLECT();
#pragma unroll
          for (int tt = 0; tt < 2; ++tt)
#pragma unroll
            for (int e = 0; e < 8; ++e) vp[tt][e] = vpn[tt][e];
        }
      }
      if (docomp) {
        const int item = ((gch0 + cd) * 8 + hd) * 2 + d;
        const bf16* ksmC = (const bf16*)sbC; const bf16* qsmC = (const bf16*)(sbC + 16896); const bf16* kTC = (const bf16*)(sbC + 33792);
        const bf16* TsmC = (const bf16*)(sbC + 51200); const bf16* QKsmC = (const bf16*)(sbC + 59904);
        const float* egcC = (const float*)(sbC + 68608); const float* edecC = (const float*)(sbC + 68864); const float* betasC = (const float*)(sbC + 69120);
        const float eglast = __expf(GC[item * 64 + 63]);
        const int rowb = ss + (d ? len - 1 - 64 * cd : 64 * cd);
        bf16* Ob = obuf + (size_t)rowb * DNP + d * 1024 + hd * 128;
        const int ors = d ? -DNP : DNP;
      f32x16 ks[2];
#pragma unroll
      for (int tt = 0; tt < 2; ++tt)
#pragma unroll
        for (int i = 0; i < 16; ++i) ks[tt][i] = 0.f;
      {
        const unsigned a0 = (unsigned)(size_t)sbC + (unsigned)((r * 132 + 4 * h_) * 2), a1 = a0 + 32 * 132 * 2;
        {
          bf16x8 fa[8];
          SC_G8(fa, a0, a1, 0);
          SC_TIE8(fa);
#pragma unroll
          for (int mt = 0; mt < 2; ++mt)
#pragma unroll
            for (int s2 = 0; s2 < 2; ++s2) {
              const bf16x8 bS = pack8(S[mt], s2);
#pragma unroll
              for (int tt = 0; tt < 2; ++tt) ks[tt] = MFMA(fa[(mt * 2 + s2) * 2 + tt], bS, ks[tt]);
            }
        }
        {
          bf16x8 fb[8];
          SC_G8(fb, a0, a1, 16);
          SC_TIE8(fb);
#pragma unroll
          for (int mt = 0; mt < 2; ++mt)
#pragma unroll
            for (int s2 = 0; s2 < 2; ++s2) {
              const bf16x8 bS = pack8(S[2 + mt], s2);
#pragma unroll
              for (int tt = 0; tt < 2; ++tt) ks[tt] = MFMA(fb[(mt * 2 + s2) * 2 + tt], bS, ks[tt]);
            }
        }
      }
      __builtin_amdgcn_sched_barrier(0);
#pragma unroll
      for (int tt = 0; tt < 2; ++tt)
#pragma unroll
        for (int q4 = 0; q4 < 4; ++q4) {
          const float4 eg = *(const float4*)(egcC + 32 * tt + 8 * q4 + 4 * h_);
          const float4 be = *(const float4*)(betasC + 32 * tt + 8 * q4 + 4 * h_);
          ks[tt][4 * q4 + 0] = be.x * (bflo(vp[tt][2 * q4]) - eg.x * ks[tt][4 * q4 + 0]);
          ks[tt][4 * q4 + 1] = be.y * (bfhi(vp[tt][2 * q4]) - eg.y * ks[tt][4 * q4 + 1]);
          ks[tt][4 * q4 + 2] = be.z * (bflo(vp[tt][2 * q4 + 1]) - eg.z * ks[tt][4 * q4 + 2]);
          ks[tt][4 * q4 + 3] = be.w * (bfhi(vp[tt][2 * q4 + 1]) - eg.w * ks[tt][4 * q4 + 3]);
        }
      __builtin_amdgcn_sched_barrier(0);
      f32x16 vn[2];
#pragma unroll
      for (int tt = 0; tt < 2; ++tt)
#pragma unroll
        for (int i = 0; i < 16; ++i) vn[tt][i] = 0.f;
      {
        bf16x8 fa[6];
        const unsigned a0 = (unsigned)(size_t)sbC + 51200u + (unsigned)((r * 68 + 4 * h_) * 2), a1 = a0 + 32 * 68 * 2;
        SC_G6(fa, a0, a1);
        SC_TIE6(fa);
        const bf16x8 bR00 = pack8(ks[0], 0), bR01 = pack8(ks[0], 1), bR10 = pack8(ks[1], 0), bR11 = pack8(ks[1], 1);
        vn[0] = MFMA(fa[0], bR00, vn[0]); vn[1] = MFMA(fa[1], bR00, vn[1]);
        vn[0] = MFMA(fa[2], bR01, vn[0]); vn[1] = MFMA(fa[3], bR01, vn[1]);
        vn[1] = MFMA(fa[4], bR10, vn[1]); vn[1] = MFMA(fa[5], bR11, vn[1]);
      }
      __builtin_amdgcn_sched_barrier(0);
      f32x16 oa[2];
#pragma unroll
      for (int tt = 0; tt < 2; ++tt)
#pragma unroll
        for (int i = 0; i < 16; ++i) oa[tt][i] = 0.f;
      {
        const unsigned a0 = (unsigned)(size_t)sbC + 16896u + (unsigned)((r * 132 + 4 * h_) * 2), a1 = a0 + 32 * 132 * 2;
        {
          bf16x8 fa[8];
          SC_G8(fa, a0, a1, 0);
          SC_TIE8(fa);
#pragma unroll
          for (int mt = 0; mt < 2; ++mt)
#pragma unroll
            for (int s2 = 0; s2 < 2; ++s2) {
              const bf16x8 bS = pack8(S[mt], s2);
#pragma unroll
              for (int tt = 0; tt < 2; ++tt) oa[tt] = MFMA(fa[(mt * 2 + s2) * 2 + tt], bS, oa[tt]);
            }
        }
        {
          bf16x8 fb[8];
          SC_G8(fb, a0, a1, 16);
          SC_TIE8(fb);
#pragma unroll
          for (int mt = 0; mt < 2; ++mt)
#pragma unroll
            for (int s2 = 0; s2 < 2; ++s2) {
              const bf16x8 bS = pack8(S[2 + mt], s2);
#pragma unroll
              for (int tt = 0; tt < 2; ++tt) oa[tt] = MFMA(fb[(mt * 2 + s2) * 2 + tt], bS, oa[tt]);
            }
        }
      }
#pragma unroll
      for (int tt = 0; tt < 2; ++tt)
#pragma unroll
        for (int q4 = 0; q4 < 4; ++q4) {
          const float4 eg = *(const float4*)(egcC + 32 * tt + 8 * q4 + 4 * h_);
          oa[tt][4 * q4 + 0] *= eg.x; oa[tt][4 * q4 + 1] *= eg.y; oa[tt][4 * q4 + 2] *= eg.z; oa[tt][4 * q4 + 3] *= eg.w;
        }
      {
        bf16x8 fa[6];
        const unsigned a0 = (unsigned)(size_t)sbC + 59904u + (unsigned)((r * 68 + 4 * h_) * 2), a1 = a0 + 32 * 68 * 2;
        SC_G6(fa, a0, a1);
        SC_TIE6(fa);
        const bf16x8 bV00 = pack8(vn[0], 0), bV01 = pack8(vn[0], 1), bV10 = pack8(vn[1], 0), bV11 = pack8(vn[1], 1);
        oa[0] = MFMA(fa[0], bV00, oa[0]); oa[1] = MFMA(fa[1], bV00, oa[1]);
        oa[0] = MFMA(fa[2], bV01, oa[0]); oa[1] = MFMA(fa[3], bV01, oa[1]);
        oa[1] = MFMA(fa[4], bV10, oa[1]); oa[1] = MFMA(fa[5], bV11, oa[1]);
      }
#pragma unroll
      for (int tt = 0; tt < 2; ++tt)
#pragma unroll
        for (int i = 0; i < 16; ++i) {
          const int t = 32 * tt + crow(i, h_);
          Ob[t * ors + dv] = f2bf(oa[tt][i]);
        }
      __builtin_amdgcn_sched_barrier(0);
#pragma unroll
      for (int tt = 0; tt < 2; ++tt)
#pragma unroll
        for (int q4 = 0; q4 < 4; ++q4) {
          const float4 ed = *(const float4*)(edecC + 32 * tt + 8 * q4 + 4 * h_);
          vn[tt][4 * q4 + 0] *= ed.x; vn[tt][4 * q4 + 1] *= ed.y; vn[tt][4 * q4 + 2] *= ed.z; vn[tt][4 * q4 + 3] *= ed.w;
        }
#pragma unroll
      for (int mt = 0; mt < 4; ++mt)
#pragma unroll
        for (int i = 0; i < 16; ++i) S[mt][i] *= eglast;
      {
        const unsigned b0 = (unsigned)(size_t)sbC + 33792u + (unsigned)((r * 68 + 4 * h_) * 2);
        const unsigned b1 = b0 + 32 * 68 * 2, b2 = b0 + 64 * 68 * 2, b3 = b0 + 96 * 68 * 2;
        {
          bf16x8 fa[8];
          SC_G8T(fa, b0, b1, b2, b3, 0);
          SC_TIE8(fa);
#pragma unroll
          for (int s2 = 0; s2 < 2; ++s2) {
            const bf16x8 bV = pack8(vn[0], s2);
#pragma unroll
            for (int mt = 0; mt < 4; ++mt) S[mt] = MFMA(fa[s2 * 4 + mt], bV, S[mt]);
          }
        }
        {
          bf16x8 fb[8];
          SC_G8T(fb, b0, b1, b2, b3, 8);
          SC_TIE8(fb);
#pragma unroll
          for (int s2 = 0; s2 < 2; ++s2) {
            const bf16x8 bV = pack8(vn[1], s2);
#pragma unroll
            for (int mt = 0; mt < 4; ++mt) S[mt] = MFMA(fb[s2 * 4 + mt], bV, S[mt]);
          }
        }
      }
      }
      if (lp == 1 && vld) V_COLLECT();
      __syncthreads();
    }
#undef V_COLLECT
    if (s < 16) {
      int tidB = tid0;
      asm volatile("" : "+v"(tidB));
      const int dv0 = 32 * w + (tidB & 31), h0_ = (tidB & 63) >> 5;
      float* dst = P.out + OUT_STATE + ((size_t)(((s * 2 + j) * 2 + d) * 8 + hd)) * 16384;
#pragma unroll
      for (int mt = 0; mt < 4; ++mt)
#pragma unroll
        for (int i = 0; i < 16; ++i) dst[(32 * mt + crow(i, h0_)) * 128 + dv0] = S[mt][i];
    }
  }
}

DI void phase_dngate(const Params& P, int wv, int vb, int nvb, int j) {
  const int lane = get_tid(wv) & 63, wave = get_tid(wv) >> 6;
  const bf16* proj = (const bf16*)(P.ws + OFF_P);
  bf16* H = (bf16*)(P.ws + OFF_H);
  const int nw = nvb * 4;
  const int c0 = 16 * lane;
  float g[16];
#pragma unroll
  for (int e = 0; e < 16; ++e) g[e] = P.dn_onorm_g[j * 128 + (c0 & 127) + e];
  for (int row = vb * 4 + wave; row < NTOK; row += nw) {
    const bf16* pr = proj + (size_t)row * DNP;
    uint4 a0 = *(const uint4*)(pr + c0), a1 = *(const uint4*)(pr + c0 + 8);
    uint4 b0 = *(const uint4*)(pr + 1024 + c0), b1 = *(const uint4*)(pr + 1024 + c0 + 8);
    uint4 z0 = *(const uint4*)(pr + 3072 + c0), z1 = *(const uint4*)(pr + 3072 + c0 + 8);
    unsigned au[8] = {a0.x, a0.y, a0.z, a0.w, a1.x, a1.y, a1.z, a1.w};
    unsigned bu[8] = {b0.x, b0.y, b0.z, b0.w, b1.x, b1.y, b1.z, b1.w};
    unsigned zu[8] = {z0.x, z0.y, z0.z, z0.w, z1.x, z1.y, z1.z, z1.w};
    float o[16], z[16];
    float ss = 0.f;
#pragma unroll
    for (int e = 0; e < 8; ++e) {
      o[2 * e] = bflo(au[e]) + bflo(bu[e]); o[2 * e + 1] = bfhi(au[e]) + bfhi(bu[e]);
      z[2 * e] = bflo(zu[e]); z[2 * e + 1] = bfhi(zu[e]);
      ss += o[2 * e] * o[2 * e] + o[2 * e + 1] * o[2 * e + 1];
    }
    ss += shx(ss, 1, lane); ss += shx(ss, 2, lane); ss += shx(ss, 4, lane);
    const float rstd = rsqrtf(ss * (1.f / 128.f) + EPS);
    unsigned pk[8];
#pragma unroll
    for (int e = 0; e < 8; ++e) {
      float v0 = o[2 * e] * rstd * g[2 * e] * siluf(z[2 * e]);
      float v1 = o[2 * e + 1] * rstd * g[2 * e + 1] * siluf(z[2 * e + 1]);
      pk[e] = pack2(v0, v1);
    }
    uint4* hp = (uint4*)(H + (size_t)row * 1024 + c0);
    hp[0] = make_uint4(pk[0], pk[1], pk[2], pk[3]);
    hp[1] = make_uint4(pk[4], pk[5], pk[6], pk[7]);
  }
}

DI void phase_atpost(const Params& P, int wv, int vb, int nvb, int j) {
  const int lane = get_tid(wv) & 63, wave = get_tid(wv) >> 6;
  const float* QKV = (const float*)(P.ws + OFF_P);
  bf16* Qb = (bf16*)(P.ws + OFF_AQ);
  bf16* Kb = (bf16*)(P.ws + OFF_AK);
  bf16* VT = (bf16*)(P.ws + OFF_AVT);
  const int nw = nvb * 4;
  const int f = lane & 15, hb = (lane >> 4) & 1;
  const float inv = exp2f(-(float)f * (13.287712379549449f / 16.f));
  for (int row = vb * 4 + wave; row < NTOK; row += nw) {
    const int s = seq_of_row(row), ss = seq_start(s), len = seq_len(s);
    const int t = row - ss;
    const bool smp = row >= NPR;
    const float* src = QKV + (size_t)row * ATP;
    float cs = 1.f, sn = 0.f;
    if (smp) { const float p = (float)(hb ? (t & 63) : (t >> 6)); sincosf(p * inv, &sn, &cs); }
#pragma unroll
    for (int i = 0; i < 8; ++i) {
      const int pi = i * 64 + lane;
      const int c1 = (pi >> 5) * 64 + hb * 32 + f;
      const float x1 = src[c1], x2 = src[c1 + 16];
      const float o1 = x1 * cs - x2 * sn, o2 = x1 * sn + x2 * cs;
      Qb[(size_t)row * 1024 + c1] = f2bf(o1 * 0.125f);
      Qb[(size_t)row * 1024 + c1 + 16] = f2bf(o2 * 0.125f);
    }
#pragma unroll
    for (int i = 0; i < 2; ++i) {
      const int pi = i * 64 + lane;
      const int c1 = (pi >> 5) * 64 + hb * 32 + f;
      const float x1 = src[1024 + c1], x2 = src[1024 + c1 + 16];
      const float o1 = x1 * cs - x2 * sn, o2 = x1 * sn + x2 * cs;
      Kb[(size_t)row * 256 + c1] = f2bf(o1);
      Kb[(size_t)row * 256 + c1 + 16] = f2bf(o2);
      if (!smp) {
        float* ck = P.out + OUT_CK + ((size_t)((s * 2 + j) * 256 + t)) * 256;
        ck[c1] = x1; ck[c1 + 16] = x2;
      }
    }
#pragma unroll
    for (int i = 0; i < 4; ++i) {
      const int cc = i * 64 + lane;
      const float x = src[1280 + cc];
      VT[(size_t)ss * 256 + (size_t)cc * len + t] = f2bf(x);
      if (!smp) P.out[OUT_CV + ((size_t)((s * 2 + j) * 256 + t)) * 256 + cc] = x;
    }
  }
}

DI void phase_attn(const Params& P, int wv, int vb, int nvb, int j, char* smem) {
  const int tid = get_tid(wv), lane = tid & 63, w = (tid >> 6) & 3, r = lane & 31, h_ = lane >> 5;
  const bf16* Qb = (const bf16*)(P.ws + OFF_AQ);
  const bf16* Kb = (const bf16*)(P.ws + OFF_AK);
  const bf16* VT = (const bf16*)(P.ws + OFF_AVT);
  const bf16* Kc = (const bf16*)(P.ws + OFF_KC);
  const bf16* Vct = (const bf16*)(P.ws + OFF_VCT);
  bf16* AO = (bf16*)(P.ws + OFF_H);
  bf16* Ksm = (bf16*)smem;
  bf16* Vsm = (bf16*)(smem + 4608);
  const int lk = tid >> 3, lkc = (tid & 7) * 8;
  const int ld = tid >> 2, ldc = (tid & 3) * 8;
  for (int it = vb; it < 1536; it += nvb) {
    int b, head, qblk; bool smp;
    if (it < 1024) { smp = true; b = it >> 7; head = (it >> 3) & 15; qblk = it & 7; }
    else { const int u = it - 1024; smp = false; b = u >> 5; head = (u >> 1) & 15; qblk = u & 1; }
    const int s = smp ? 16 + b : b, ss = seq_start(s), len = seq_len(s);
    const int kvh = head >> 2;
    const int qb0 = qblk * 128;
    const int q0 = qb0 + w * 32;
    const int qrow = ss + q0 + r;
    bf16x8 bq[4];
#pragma unroll
    for (int ks = 0; ks < 4; ++ks) bq[ks] = *(const bf16x8*)(Qb + (size_t)qrow * 1024 + head * 64 + ks * 16 + h_ * 8);
    float m = P.at_sink[j * 16 + head];
    float l = h_ == 0 ? 1.f : 0.f;
    f32x16 oacc[2];
#pragma unroll
    for (int dt = 0; dt < 2; ++dt)
#pragma unroll
      for (int i = 0; i < 16; ++i) oacc[dt][i] = 0.f;
    const bf16* Kp = Kb + (size_t)ss * 256 + kvh * 64;
    const bf16* VTp = VT + (size_t)ss * 256 + (size_t)kvh * 64 * len;
    const bf16* Kcp = Kc + (size_t)((b * 2 + j) * 4 + kvh) * 512 * 64;
    const bf16* Vcp = Vct + (size_t)((b * 2 + j) * 4 + kvh) * 64 * 512;
    const int klo = smp ? qb0 - 128 : 0;
    const int nloc = smp ? 12 : 8;
    const int ntile = nloc + (smp ? 16 : 0);
    uint4 kreg = make_uint4(0u, 0u, 0u, 0u), vreg = make_uint4(0u, 0u, 0u, 0u);
    if (klo >= 0) {
      kreg = *(const uint4*)(Kp + (size_t)(klo + lk) * 256 + lkc);
      vreg = *(const uint4*)(VTp + (size_t)ld * len + klo + ldc);
    }
    *(uint4*)(Ksm + lk * 72 + lkc) = kreg;
    *(uint2*)(Vsm + ld * 36 + ldc) = make_uint2(vreg.x, vreg.y);
    *(uint2*)(Vsm + ld * 36 + ldc + 4) = make_uint2(vreg.z, vreg.w);
    __syncthreads();
#pragma unroll 1
    for (int t = 0; t < ntile; ++t) {
      const bf16* Kcur = Ksm + (t & 1) * 4608;
      const bf16* Vcur = Vsm + (t & 1) * 4608;
      bool have_next = false;
      if (t + 1 < ntile) {
        const int tn = t + 1;
        if (tn < nloc) {
          const int key0n = klo + tn * 32;
          if (key0n >= 0 && key0n < len) {
            kreg = *(const uint4*)(Kp + (size_t)(key0n + lk) * 256 + lkc);
            vreg = *(const uint4*)(VTp + (size_t)ld * len + key0n + ldc);
            have_next = true;
          }
        } else {
          const int key0n = (tn - nloc) * 32;
          kreg = *(const uint4*)(Kcp + (size_t)(key0n + lk) * 64 + lkc);
          vreg = *(const uint4*)(Vcp + (size_t)ld * 512 + key0n + ldc);
          have_next = true;
        }
      }
      const bool local = t < nloc;
      const int key0 = klo + t * 32;
      const bool skip_empty = local && (key0 < 0 || key0 >= len);
      const bool skip_win = local && smp && (key0 + 31 < q0 - 128 || key0 > q0 + 31 + 128);
      if (!skip_empty && !skip_win) {
      f32x16 sa;
#pragma unroll
      for (int i = 0; i < 16; ++i) sa[i] = 0.f;
#pragma unroll
      for (int ks = 0; ks < 4; ++ks) {
        bf16x8 a = *(const bf16x8*)(Kcur + r * 72 + ks * 16 + h_ * 8);
        sa = MFMA(a, bq[ks], sa);
      }
      if (local && smp && !(key0 >= q0 + 31 - 128 && key0 + 31 <= q0 + 128)) {
        const int qpos = q0 + r;
#pragma unroll
        for (int i = 0; i < 16; ++i) {
          const int dd = qpos - (key0 + crow(i, h_));
          if (dd > 128 || dd < -128) sa[i] = -INFINITY;
        }
      }
      float tmax = sa[0];
#pragma unroll
      for (int i = 1; i < 16; ++i) tmax = fmaxf(tmax, sa[i]);
      tmax = fmaxf(tmax, shx(tmax, 32, lane));
      const float mnew = fmaxf(m, tmax);
      if (__ballot(mnew > m) != 0ull) {
        const float alpha = __expf(m - mnew);
        l *= alpha;
#pragma unroll
        for (int dt = 0; dt < 2; ++dt)
#pragma unroll
          for (int i = 0; i < 16; ++i) oacc[dt][i] *= alpha;
      }
      m = mnew;
      float ls = 0.f;
#pragma unroll
      for (int i = 0; i < 16; ++i) { sa[i] = __expf(sa[i] - mnew); ls += sa[i]; }
      l += ls;
#pragma unroll
      for (int s2 = 0; s2 < 2; ++s2) {
        const bf16x8 bp = pack8(sa, s2);
#pragma unroll
        for (int dt = 0; dt < 2; ++dt) {
          const bf16* ap = Vcur + (32 * dt + r) * 36 + 16 * s2 + 4 * h_;
          oacc[dt] = MFMA(frag2(*(const uint2*)ap, *(const uint2*)(ap + 8)), bp, oacc[dt]);
        }
      }
      }
      if (have_next) {
        bf16* Kn = Ksm + ((t + 1) & 1) * 4608;
        bf16* Vn = Vsm + ((t + 1) & 1) * 4608;
        *(uint4*)(Kn + lk * 72 + lkc) = kreg;
        *(uint2*)(Vn + ld * 36 + ldc) = make_uint2(vreg.x, vreg.y);
        *(uint2*)(Vn + ld * 36 + ldc + 4) = make_uint2(vreg.z, vreg.w);
      }
      __syncthreads();
    }
    l += shx(l, 32, lane);
    const float il = 1.f / l;
#pragma unroll
    for (int dt = 0; dt < 2; ++dt)
#pragma unroll
      for (int q4 = 0; q4 < 4; ++q4) {
        const int dd = 32 * dt + 8 * q4 + 4 * h_;
        *(uint2*)(AO + (size_t)qrow * 1024 + head * 64 + dd) =
            make_uint2(pack2(oacc[dt][4 * q4] * il, oacc[dt][4 * q4 + 1] * il), pack2(oacc[dt][4 * q4 + 2] * il, oacc[dt][4 * q4 + 3] * il));
      }
  }
}

DI void phase_ffnconv(const Params& P, int wv, int vb, int nvb, int layer) {
  const int tid = get_tid(wv);
  const bf16* halo = (const bf16*)(P.ws + OFF_HALO);
  bf16* ACT = (bf16*)(P.ws + OFF_A);
  const float* cw = P.ffn_conv_w + (size_t)layer * 3 * FF2;
  const float* cbv = P.ffn_conv_b + (size_t)layer * FF2;
  const int fl = tid & 127, which = tid >> 7;
  for (int item = vb; item < 24 * 22; item += nvb) {
    const int b = item / 22, nb = item % 22;
    const int sq = b / 3, k = b % 3 + 1;
    const int mtA = 16 + sq * 4 + (k - 1);
    const int R = NPR + sq * 1024 + 256 * k - 1;
    const bf16* HA = halo + (size_t)(mtA * 22 + nb) * 4 * 256;
    const bf16* HB = halo + (size_t)((mtA + 1) * 22 + nb) * 4 * 256;
    const bf16* pp = which ? HA + 3 * 256 : HA + 2 * 256;
    const bf16* pc = which ? HB : HA + 3 * 256;
    const bf16* pn = which ? HB + 256 : HB;
    const int f = nb * 128 + fl;
    const float ua = cw[f] * bf2f(pp[fl]) + cw[FF2 + f] * bf2f(pc[fl]) + cw[2 * FF2 + f] * bf2f(pn[fl]) + cbv[f];
    const float ub = cw[FF + f] * bf2f(pp[128 + fl]) + cw[FF2 + FF + f] * bf2f(pc[128 + fl]) + cw[2 * FF2 + FF + f] * bf2f(pn[128 + fl]) + cbv[FF + f];
    ACT[(size_t)(R + which) * FF + f] = f2bf(ua / (1.f + __expf(-ua)) * ub);
  }
}

DI void run_phase(const Params& P, int wv8, int ph, char* smem8) {
  const int sub = wv8 >> 2, wv = wv8 & 3;
  int vb = (int)blockIdx.x * 2 + sub;
  asm volatile("" : "+s"(vb));
  const int nvb = (int)gridDim.x * 2;
  char* smem = smem8 + sub * LDS_BYTES;
  const float* mod = (const float*)(P.ws + OFF_MOD);
  if (ph == 0) { phase_pre(P, wv, vb, nvb, smem); return; }
  int layer, st;
  if (ph == 1) { layer = -1; st = 0; }
  else if (ph < 13) { layer = 0; st = ph - 2; }
  else if (ph < 21) { layer = 1; st = ph - 13; }
  else if (ph < 32) { layer = 2; st = ph - 21; }
  else { layer = 3; st = ph - 32; }
  const int j = layer >> 1;
  const bool isdn = (layer & 1) == 0;
  int kind;
  int fst;
  if (layer < 0) { kind = 1; fst = -1; }
  else if (isdn) {
    if (st == 0) { kind = 0; fst = -2; } else if (st == 1) { kind = 2; fst = -1; } else if (st == 2) { kind = 3; fst = -1; }
    else if (st == 3) { kind = 4; fst = -1; } else if (st == 4) { kind = 5; fst = -1; } else { fst = st - 5; kind = -1; }
  } else {
    if (st == 0) { kind = 0; fst = -2; } else if (st == 1) { kind = 7; fst = -1; }
    else { fst = st - 2; kind = -1; }
  }
  if (kind < 0) { kind = (fst == 0 || fst == 2 || fst == 4) ? 0 : (fst == 3 ? 8 : 1); }

  if (kind == 0) {
    const bf16* A; int lda; const bf16* Bt; int K, Npad, N; void* C; int ldc, epi;
    const bf16* H = (const bf16*)(P.ws + OFF_H);
    if (fst == -2) {
      A = H; lda = 1024; K = 1024;
      if (isdn) { Bt = (const bf16*)(P.ws + OFF_WIN + j * SZ_WIN); Npad = DNPAD; N = DNP; C = P.ws + OFF_P; ldc = DNP; epi = 0; }
      else { Bt = (const bf16*)(P.ws + OFF_WQKV + j * SZ_WQKV); Npad = ATP; N = ATP; C = P.ws + OFF_P; ldc = ATP; epi = 4; }
    } else if (fst == 0) {
      A = H; lda = 1024; K = 1024; Npad = 1024; N = 1024; C = P.ws + OFF_P; ldc = 1024; epi = 0;
      Bt = isdn ? (const bf16*)(P.ws + OFF_WOUT + j * SZ_WSQ) : (const bf16*)(P.ws + OFF_WO + j * SZ_WSQ);
    } else if (fst == 2) {
      A = H; lda = 1024; K = 1024; Npad = FF2; N = FF2; C = P.ws + OFF_A; ldc = FF; epi = 3;
      Bt = (const bf16*)(P.ws + OFF_WUP + layer * SZ_WUP);
    } else {
      A = (const bf16*)(P.ws + OFF_A); lda = FF; K = FF; Npad = 1024; N = 1024; C = P.ws + OFF_P; ldc = 1024; epi = 0;
      Bt = (const bf16*)(P.ws + OFF_WDN + layer * SZ_WDN);
    }
    phase_gemm(wv8, A, lda, Bt, K, Npad, N, C, ldc, epi, P.ffn_conv_w + (size_t)(layer < 0 ? 0 : layer) * 3 * FF2, P.ffn_conv_b + (size_t)(layer < 0 ? 0 : layer) * FF2, (bf16*)(P.ws + OFF_HALO), P, j < 0 ? 0 : j, smem8);
  } else if (kind == 1) {
    int mode, gate_idx, do_h, shift_idx, scale_idx;
    const float *ga, *modg, *gb, *modn;
    if (layer < 0) {
      mode = 0; ga = P.norm_g; modg = mod; gate_idx = 0; do_h = 1; gb = P.norm_g; modn = mod; shift_idx = 0; scale_idx = 1;
    } else if (fst == 1) {
      mode = 1; ga = P.norm_g + (layer * 4 + 1) * 1024; modg = mod + layer * 9 * 6144; gate_idx = 2;
      do_h = 1; gb = P.norm_g + (layer * 4 + 2) * 1024; modn = modg; shift_idx = 3; scale_idx = 4;
    } else {
      mode = 1; ga = P.norm_g + (layer * 4 + 3) * 1024; modg = mod + layer * 9 * 6144; gate_idx = 5;
      do_h = layer < 3 ? 1 : 0;
      const int nl = layer < 3 ? layer + 1 : 3;
      gb = P.norm_g + (nl * 4 + 0) * 1024; modn = mod + nl * 9 * 6144; shift_idx = 0; scale_idx = 1;
    }
    phase_rowepi(P, wv, vb, nvb, mode, ga, modg, gate_idx, do_h, gb, modn, shift_idx, scale_idx);
  } else if (kind == 2) phase_dnconv(P, wv, vb, nvb, j);
  else if (kind == 3) phase_dnprep(P, wv, vb, nvb, j, smem);
  else if (kind == 4) phase_dnscan(P, wv, vb, nvb, j, smem);
  else if (kind == 5) phase_dngate(P, wv, vb, nvb, j);
  else if (kind == 6) { }
  else if (kind == 7) phase_attn(P, wv, vb, nvb, j, smem);
  else phase_ffnconv(P, wv, vb, nvb, layer);
}


#define XB_TMO      128
#define XB_XCNT(j)  (256  + 64 * (j))
#define XB_XSUB(j)  (1280 + 64 * (j))
#define XB_XGEN(j)  (2304 + 64 * (j))
#define XB_TOP      3328
#define XB_TOPGEN   3392
#define XCD_BAR_WORDS 3456
#define XB_SPIN_CAP (1u << 18)
#define LAS __attribute__((address_space(3)))
DI unsigned xb_ld(unsigned* p) { return __hip_atomic_load(p, __ATOMIC_RELAXED, __HIP_MEMORY_SCOPE_AGENT); }
DI unsigned xb_add(unsigned* p, unsigned v) { return __hip_atomic_fetch_add(p, v, __ATOMIC_RELAXED, __HIP_MEMORY_SCOPE_AGENT); }
DI unsigned xb_xcc_id() { return (unsigned)__builtin_amdgcn_s_getreg((3 << 11) | 20) & 0xFu; }
#define XB_SPIN(cond, bar) do { unsigned _sp = 0; while (cond) { __builtin_amdgcn_s_sleep(1); \
    if ((++_sp & 255u) == 0u) { if (xb_ld(&(bar)[XB_TMO])) break; if (_sp > XB_SPIN_CAP) { atomicAdd(&(bar)[XB_TMO], 1u); break; } } } } while (0)
struct XcdBarrier { unsigned* bar; unsigned x; volatile LAS unsigned* st; };
DI XcdBarrier xcd_barrier_post(unsigned* bar, volatile LAS unsigned* st) {
  XcdBarrier b; b.bar = bar; b.x = xb_xcc_id(); b.st = st;
  if (threadIdx.x == 0) (void)xb_add(&bar[XB_XCNT(b.x)], 1u);
  return b;
}
DI void xcd_barrier_complete(unsigned* bar, unsigned x, unsigned& nloc, unsigned& nx) {
  const unsigned G = gridDim.x * gridDim.y * gridDim.z;
  unsigned sum, cnt, mine, sp = 0u;
  for (;;) {
    sum = 0u; cnt = 0u; mine = 0u;
#pragma unroll
    for (unsigned j = 0; j < 16; ++j) { const unsigned c = xb_ld(&bar[XB_XCNT(j)]); sum += c; cnt += (c > 0u) ? 1u : 0u; mine = (j == x) ? c : mine; }
    if (sum == G) break;
    __builtin_amdgcn_s_sleep(1);
    if ((++sp & 255u) == 0u) { if (xb_ld(&bar[XB_TMO])) break; if (sp > XB_SPIN_CAP) { atomicAdd(&bar[XB_TMO], 1u); break; } }
  }
  nloc = mine > 0u ? mine : 1u; nx = cnt > 0u ? cnt : 1u;
}
DI void xcd_barrier(const XcdBarrier& b, int wv) {
  asm volatile("s_waitcnt vmcnt(0)" ::: "memory");
  __syncthreads();
  if (wv == 0 && lane_id_opaque() == 0) {
    unsigned* bar = b.bar;
    __builtin_amdgcn_s_waitcnt(0);
    unsigned nloc = b.st[0], nx = b.st[1];
    if (nloc == 0u) { xcd_barrier_complete(bar, b.x, nloc, nx); b.st[0] = nloc; b.st[1] = nx; }
    const unsigned old = xb_add(&bar[XB_XSUB(b.x)], 1u);
    const unsigned gen = old / nloc;
    if (old + 1u == (gen + 1u) * nloc) {
      __builtin_amdgcn_fence(__ATOMIC_RELEASE, "agent");
      asm volatile("s_waitcnt vmcnt(0)" ::: "memory");
      const unsigned og = xb_add(&bar[XB_TOP], 1u);
      const unsigned tg = og / nx;
      if (og + 1u == (tg + 1u) * nx) xb_add(&bar[XB_TOPGEN], 1u);
      else XB_SPIN(xb_ld(&bar[XB_TOPGEN]) == tg, bar);
      __builtin_amdgcn_fence(__ATOMIC_ACQUIRE, "agent");
      xb_add(&bar[XB_XGEN(b.x)], 1u);
      asm volatile("s_waitcnt vmcnt(0)" ::: "memory");
    } else {
      XB_SPIN(xb_ld(&bar[XB_XGEN(b.x)]) == gen, bar);
      __builtin_amdgcn_fence(__ATOMIC_ACQUIRE, "agent");
      asm volatile("s_waitcnt vmcnt(0)" ::: "memory");
    }
  }
  __syncthreads();
}
constexpr size_t OFF_BAR = 917504;

#ifndef DUPMASK
#define DUPMASK 0
#endif
DI int phase_kind(int ph) {
  if (ph == 0) return 9;
  if (ph == 1) return 1;
  int st; bool isdn;
  if (ph < 13) { isdn = true; st = ph - 2; } else if (ph < 21) { isdn = false; st = ph - 13; }
  else if (ph < 32) { isdn = true; st = ph - 21; } else { isdn = false; st = ph - 32; }
  int fst;
  if (isdn) { if (st == 0) return 0; if (st <= 4) return st + 1; fst = st - 5; }
  else { if (st == 0) return 0; if (st == 1) return 7; fst = st - 2; }
  return (fst == 0 || fst == 2 || fst == 4) ? 0 : (fst == 3 ? 8 : 1);
}
__global__ void __launch_bounds__(512, 2) mega_kernel(Params P, int p0, int p1) {
  __shared__ __attribute__((aligned(1024))) char smem[2 * LDS_BYTES];
  __shared__ uint4 xb_words;
  const int wv = __builtin_amdgcn_readfirstlane((int)(threadIdx.x >> 6));
  cg::grid_group grid = cg::this_grid();
  if (threadIdx.x == 0) xb_words = make_uint4(0u, 0u, 0u, 0u);
  __syncthreads();
  if (p1 < 0) grid.sync();
  XcdBarrier xb = xcd_barrier_post((unsigned*)(P.ws + OFF_BAR), (volatile LAS unsigned*)&xb_words);
#if DUPMASK
  int ph = p0, q = 0;
  while (ph < p1) {
    run_phase(P, wv, ph, smem);
    const int reps = 1 + ((DUPMASK >> phase_kind(ph)) & 1);
    ++q;
    if (q >= reps) { q = 0; ++ph; }
    if (ph < p1) xcd_barrier(xb, wv);
    if ((DUPMASK >> 10) & 1) xcd_barrier(xb, wv);
  }
#else
  for (int ph = p0; ph < p1; ++ph) {
    run_phase(P, wv, ph, smem);
    if (ph + 1 < p1) xcd_barrier(xb, wv);
    if (ph + 1 < p1) { const int nk = phase_kind(ph + 1); if (nk == 7 || nk == 8 || phase_kind(ph) == 7) xcd_barrier(xb, wv); }
  }
#endif
}

extern "C" void kernel_launch(void* const* d_in, const int* in_sizes, int n_in, void* d_out, int out_size,
                              void* d_ws, size_t ws_size, hipStream_t stream) {
  static int grid_blocks = 0;
  if (!grid_blocks) {
    int dev = 0, cus = 0, per_cu = 0;
    hipGetDevice(&dev);
    hipDeviceGetAttribute(&cus, hipDeviceAttributeMultiprocessorCount, dev);
    hipOccupancyMaxActiveBlocksPerMultiprocessor(&per_cu, mega_kernel, 512, 0);
    if (per_cu > 1) per_cu = 1;
    if (per_cu < 1) per_cu = 1;
    grid_blocks = cus * per_cu;
  }
  if (ws_size < WS_NEEDED) { fprintf(stderr, "workspace too small: %zu < %zu\n", ws_size, (size_t)WS_NEEDED); return; }
  Params p;
  memset(&p, 0, sizeof(p));
  const float** fp = (const float**)&p;
  for (int i = 0; i < 23; ++i) fp[i] = (const float*)d_in[i];
  p.out = (float*)d_out;
  p.ws = (char*)d_ws;
  hipMemsetAsync((char*)d_ws + OFF_BAR, 0, XCD_BAR_WORDS * sizeof(unsigned), stream);
#if MULTI_LAUNCH
  for (int ph = 0; ph < NPH; ++ph) hipLaunchKernelGGL(mega_kernel, dim3(grid_blocks), dim3(512), 0, stream, p, ph, ph + 1);
#else
  int p0 = 0, p1 = NPH;
  void* args[] = {&p, &p0, &p1};
  hipError_t e = hipLaunchCooperativeKernel((void*)mega_kernel, dim3(grid_blocks), dim3(512), args, 0, stream);
  if (e != hipSuccess) fprintf(stderr, "cooperative launch failed: %s (grid %d)\n", hipGetErrorString(e), grid_blocks);
#endif
}
```
